# Optimizing an MI355X kernel written in HIP

```python
import math
import jax, jax.numpy as jnp
from jax import lax
import numpy as np

D_MODEL = 1024
BATCH = 8
SEQ = 4096
DEPTH = 2
DEC_BATCH = 4
DEC_SEQ = 4096
PAST_LEN = 128

HEAD_DIM = 64
HEADS_PER_GROUP = 4
WINDOWS = (128, 512, 2048)
DILATIONS = (1, 4, 16)
N_GROUPS = 3
RADII = tuple(w // (2 * r) for w, r in zip(WINDOWS, DILATIONS))
ATTN_QKV_WIDTH = N_GROUPS * HEADS_PER_GROUP * HEAD_DIM
ATTN_OUT_WIDTH = HEADS_PER_GROUP * HEAD_DIM
CONV_WIDTH = D_MODEL
CONV_KERNEL = 3
D_FF = 4 * D_MODEL
ROPE_THETA = 10000.0
NORM_EPS = 1e-6
NEG_INF = -1e30
SPLIT_SIZES = (ATTN_QKV_WIDTH, ATTN_QKV_WIDTH, ATTN_QKV_WIDTH,
               CONV_WIDTH, CONV_WIDTH, CONV_WIDTH, D_MODEL, D_MODEL)
IN_WIDTH = sum(SPLIT_SIZES)

kernel_name = "hybrid_dilated_attn_shortconv_encoder"


def rms_norm(x, g):
    xf = x.astype(jnp.float32)
    y = xf * lax.rsqrt(jnp.mean(xf * xf, axis=-1, keepdims=True) + NORM_EPS)
    return (y * g.astype(jnp.float32)).astype(x.dtype)


def rope_tables(seq):
    inv = ROPE_THETA ** (-jnp.arange(0, HEAD_DIM, 2, dtype=jnp.float32) / HEAD_DIM)
    ang = jnp.arange(seq, dtype=jnp.float32)[:, None] * inv[None, :]
    ang = jnp.concatenate([ang, ang], axis=-1)
    return jnp.cos(ang), jnp.sin(ang)


def apply_rope(t, cos, sin):
    tf = t.astype(jnp.float32)
    half = HEAD_DIM // 2
    rot = jnp.concatenate([-tf[..., half:], tf[..., :half]], axis=-1)
    c = cos[None, :, None, None, :]
    s = sin[None, :, None, None, :]
    return (tf * c + rot * s).astype(t.dtype)


def dilated_window_attention(q, k, v, dilation, radius):
    b, s, h, d = q.shape
    L = s // dilation
    blk = radius
    nblk = -(-L // blk)
    lp = nblk * blk

    def to_classes(t):
        return t.reshape(b, L, dilation, h, d)

    qc = jnp.pad(to_classes(q), ((0, 0), (0, lp - L), (0, 0), (0, 0), (0, 0)))
    kv_pad = ((0, 0), (blk, lp - L + blk), (0, 0), (0, 0), (0, 0))
    kc = jnp.pad(to_classes(k), kv_pad)
    vc = jnp.pad(to_classes(v), kv_pad)
    qb = qc.reshape(b, nblk, blk, dilation, h, d)
    kb = kc.reshape(b, nblk + 2, blk, dilation, h, d)
    vb = vc.reshape(b, nblk + 2, blk, dilation, h, d)
    kw = jnp.concatenate([kb[:, :-2], kb[:, 1:-1], kb[:, 2:]], axis=2)
    vw = jnp.concatenate([vb[:, :-2], vb[:, 1:-1], vb[:, 2:]], axis=2)

    scores = jnp.einsum('bnqrhd,bnkrhd->bnrhqk', qb, kw,
                        preferred_element_type=jnp.float32) * (d ** -0.5)
    q_pos = jnp.arange(nblk)[:, None] * blk + jnp.arange(blk)[None, :]
    k_pos = jnp.arange(nblk)[:, None] * blk - blk + jnp.arange(3 * blk)[None, :]
    kp = k_pos[:, None, :]
    valid = (jnp.abs(q_pos[:, :, None] - kp) <= radius) & (kp >= 0) & (kp < L)
    scores = jnp.where(valid[None, :, None, None], scores, NEG_INF)
    m = jnp.max(scores, axis=-1, keepdims=True)
    p = jnp.exp(scores - m)
    l = jnp.sum(p, axis=-1, keepdims=True)
    o = jnp.einsum('bnrhqk,bnkrhd->bnrhqd', p, vw.astype(jnp.float32)) / l
    lse = (m + jnp.log(l))[..., 0]
    o = jnp.transpose(o, (0, 1, 4, 2, 3, 5)).reshape(b, lp, dilation, h, d)[:, :L]
    lse = jnp.transpose(lse, (0, 1, 4, 2, 3)).reshape(b, lp, dilation, h)[:, :L]
    return o.reshape(b, s, h, d), lse.reshape(b, s, h)


def encoder_layer(x, g_mix_pre, g_mix_post, g_mlp_pre, g_mlp_post, w_in, w_attn_out,
                  conv_w, w_conv_out, w_out, w_up, w_down, cos, sin):
    b, s, _ = x.shape
    hn = rms_norm(x, g_mix_pre)
    z = hn @ w_in
    q, k, v, conv_b, conv_c, conv_h, gate_a, gate_c = jnp.split(
        z, np.cumsum(SPLIT_SIZES)[:-1].tolist(), axis=-1)

    grp = (b, s, N_GROUPS, HEADS_PER_GROUP, HEAD_DIM)
    q = apply_rope(q.reshape(grp), cos, sin)
    k = apply_rope(k.reshape(grp), cos, sin)
    v = v.reshape(grp)
    outs, lses = [], []
    for g in range(N_GROUPS):
        o_g, lse_g = dilated_window_attention(q[:, :, g], k[:, :, g], v[:, :, g],
                                              DILATIONS[g], RADII[g])
        outs.append(o_g)
        lses.append(lse_g)
    wts = jax.nn.softmax(jnp.stack(lses, axis=0), axis=0)
    attn = jnp.sum(wts[..., None] * jnp.stack(outs, axis=0), axis=0)
    y_a = attn.astype(x.dtype).reshape(b, s, ATTN_OUT_WIDTH) @ w_attn_out

    u = conv_c * conv_h
    up = jnp.pad(u, ((0, 0), (1, 1), (0, 0)))
    conv = up[:, :-2] * conv_w[0] + up[:, 1:-1] * conv_w[1] + up[:, 2:] * conv_w[2]
    y_c = (conv_b * conv) @ w_conv_out

    mixed = (jax.nn.sigmoid(gate_a) * y_a + jax.nn.sigmoid(gate_c) * y_c) @ w_out
    x = x + rms_norm(mixed, g_mix_post)

    hm = rms_norm(x, g_mlp_pre)
    f = jnp.square(jax.nn.relu(hm @ w_up)) @ w_down
    return x + rms_norm(f, g_mlp_post)


def run_trunk(x, g_mix_pre, g_mix_post, g_mlp_pre, g_mlp_post, w_in, w_attn_out,
              conv_w, w_conv_out, w_out, w_up, w_down):
    cos, sin = rope_tables(x.shape[1])
    for i in range(DEPTH):
        x = encoder_layer(x, g_mix_pre[i], g_mix_post[i], g_mlp_pre[i], g_mlp_post[i],
                          w_in[i], w_attn_out[i], conv_w[i], w_conv_out[i], w_out[i],
                          w_up[i], w_down[i], cos, sin)
    return x


def setup_inputs(seed: int = 0) -> dict:
    key = jax.random.key(seed)
    ks = jax.random.split(key, 16)
    f32 = jnp.float32

    def nrm(k, shape, scale):
        return jax.random.normal(k, shape, f32) * scale

    def gain(k):
        return 1.0 + 0.02 * jax.random.normal(k, (DEPTH, D_MODEL), f32)

    return {
        "x_prompt": jax.random.normal(ks[0], (BATCH, SEQ, D_MODEL), f32),
        "x_sample": jax.random.normal(ks[1], (DEC_BATCH, DEC_SEQ, D_MODEL), f32),
        "g_mix_pre": gain(ks[2]),
        "g_mix_post": gain(ks[3]),
        "g_mlp_pre": gain(ks[4]),
        "g_mlp_post": gain(ks[5]),
        "w_in": nrm(ks[6], (DEPTH, D_MODEL, IN_WIDTH), D_MODEL ** -0.5),
        "w_attn_out": nrm(ks[7], (DEPTH, ATTN_OUT_WIDTH, D_MODEL), ATTN_OUT_WIDTH ** -0.5),
        "conv_w": nrm(ks[8], (DEPTH, CONV_KERNEL, CONV_WIDTH), CONV_KERNEL ** -0.5),
        "w_conv_out": nrm(ks[9], (DEPTH, CONV_WIDTH, D_MODEL), CONV_WIDTH ** -0.5),
        "w_out": nrm(ks[10], (DEPTH, D_MODEL, D_MODEL), D_MODEL ** -0.5),
        "w_up": nrm(ks[11], (DEPTH, D_MODEL, D_FF), D_MODEL ** -0.5),
        "w_down": nrm(ks[12], (DEPTH, D_FF, D_MODEL), D_FF ** -0.5),
    }


def reference(x_prompt, x_sample, g_mix_pre, g_mix_post, g_mlp_pre, g_mlp_post, w_in,
              w_attn_out, conv_w, w_conv_out, w_out, w_up, w_down):
    y_prompt = run_trunk(x_prompt, g_mix_pre, g_mix_post, g_mlp_pre, g_mlp_post, w_in,
                         w_attn_out, conv_w, w_conv_out, w_out, w_up, w_down)
    y_sample = run_trunk(x_sample, g_mix_pre, g_mix_post, g_mlp_pre, g_mlp_post, w_in,
                         w_attn_out, conv_w, w_conv_out, w_out, w_up, w_down)
    return (y_prompt, y_sample)
```

```cpp
#include <hip/hip_runtime.h>
#include <hip/hip_cooperative_groups.h>
#include <cstdio>
#include <cstdint>
namespace cg = cooperative_groups;
namespace pg8 {
#define PG8_LAS __attribute__((address_space(3)))
typedef unsigned short bf16_t;
typedef short bf16x8 __attribute__((ext_vector_type(8)));
typedef float f32x4 __attribute__((ext_vector_type(4)));
typedef unsigned u32x4 __attribute__((ext_vector_type(4)));
constexpr int BM = 256, BK = 64, HALF = 128, HTB = HALF * BK * 2  , STAGE_BYTES = 8 * HTB, NXCD = 8, WGM = 8;

__host__ __device__ __forceinline__ int lds_byte(int r, int c) { const int st = (r >> 4) * 2 + (c >> 5), rr = r & 15, cc = c & 31, ob = rr * 64 + cc * 2; return st * 1024 + (ob ^ (((ob >> 9) & 1) << 5)); }
__host__ __device__ __forceinline__ void stage_rc(int b, int& R, int& C) { const int st = b / 1024, sb = b % 1024, swz = sb ^ (((sb >> 9) & 1) << 5); R = (st >> 1) * 16 + swz / 64; C = (st & 1) * 32 + (swz % 64) / 2; }
__host__ __device__ __forceinline__ int perm32(int rho) { const int n = rho >> 4, i = rho & 15; return 8 * (i >> 2) + 4 * n + (i & 3); }

struct Unit { int pm, pn; };
struct Gemm { const bf16_t* A; const bf16_t* Bt; int M, N, K; };

struct StaticOrder {
    int nM, nN, nwg, G, c;
    __host__ __device__ void init(int M, int N, int G_, int c_) { nM = M / BM; nN = N / BM; nwg = nM * nN; G = G_; c = c_; }
    __host__ __device__ bool next(int i, Unit& u) const {
        const long L = (long)i * G + c; if (L >= nwg) return false;
        int wgid = (int)L; { const int q = nwg / NXCD, r = nwg % NXCD, xcd = wgid % NXCD, off = wgid / NXCD; wgid = (xcd < r ? xcd * (q + 1) : r * (q + 1) + (xcd - r) * q) + off; }
        const int nig = WGM * nN, gid = wgid / nig, fm = gid * WGM, gsz = (nM - fm) < WGM ? (nM - fm) : WGM;
        u.pm = fm + ((wgid % nig) % gsz); u.pn = (wgid % nig) / gsz; return true;
    }
    __device__ __forceinline__ void a_ready(const Unit&) const {}
    __device__ __forceinline__ void done(const Unit&) const {}
};

__device__ __forceinline__ unsigned cvt_pk_bf16(float lo, float hi) { unsigned r; asm volatile("v_cvt_pk_bf16_f32 %0, %1, %2" : "=v"(r) : "v"(lo), "v"(hi)); return r; }
__device__ __forceinline__ float bf_lo(unsigned w) { return __uint_as_float(w << 16); }
__device__ __forceinline__ float bf_hi(unsigned w) { return __uint_as_float(w & 0xffff0000u); }
__device__ __forceinline__ float sigm(float x) { return __builtin_amdgcn_rcpf(1.0f + __builtin_amdgcn_exp2f(-1.4426950408889634f * x)); }
constexpr float QSCALE = 0.125f * 1.4426950408889634f;

struct EpiIn {
    static constexpr bool PERM = true, AFTER_DRAIN = false;
    bf16_t* Z; const float* rs; const float* rope; int ldc;
    __device__ __forceinline__ void operator()(const f32x4 (&acc)[2][2][4][2], const Unit& u, int wr, int wc, int fr, int fq) const {
        const int row0 = u.pm * BM + wr * 64 + fr, col0 = u.pn * BM + wc * 32 + 8 * fq;
        const int G = 4 * (wc & 1) + fq;
        if (u.pn < 6) {
            const float qs = u.pn < 3 ? QSCALE : 1.0f;
#pragma unroll
            for (int ai = 0; ai < 2; ++ai)
#pragma unroll
                for (int m = 0; m < 4; ++m) {
                    const int row = row0 + ai * HALF + m * 16; const float s = rs[row] * qs;
                    const f32x4* rp = (const f32x4*)(rope + ((size_t)(row & 4095) * 32 + 4 * G) * 2);
                    const f32x4 r0 = rp[0], r1 = rp[1];
                    const f32x4 cs = (f32x4){r0[0], r0[2], r1[0], r1[2]}, sn = (f32x4){r0[1], r0[3], r1[1], r1[3]};
                    bf16_t* rowp = Z + (size_t)row * ldc + col0;
#pragma unroll
                    for (int bj = 0; bj < 2; ++bj) {
                        const f32x4 lo = acc[ai][bj][m][0] * s, hi = acc[ai][bj][m][1] * s;
                        const f32x4 ol = lo * cs - hi * sn, oh = hi * cs + lo * sn;
                        u32x4 w; w.x = cvt_pk_bf16(ol[0], ol[1]); w.y = cvt_pk_bf16(ol[2], ol[3]); w.z = cvt_pk_bf16(oh[0], oh[1]); w.w = cvt_pk_bf16(oh[2], oh[3]);
                        *(u32x4*)(rowp + bj * HALF) = w; }
                }
        } else {
#pragma unroll
            for (int ai = 0; ai < 2; ++ai)
#pragma unroll
                for (int m = 0; m < 4; ++m) {
                    const int row = row0 + ai * HALF + m * 16; const float s = rs[row];
                    bf16_t* rowp = Z + (size_t)row * ldc + col0;
#pragma unroll
                    for (int bj = 0; bj < 2; ++bj) {
                        const f32x4 v0 = acc[ai][bj][m][0] * s, v1 = acc[ai][bj][m][1] * s;
                        u32x4 w; w.x = cvt_pk_bf16(v0[0], v0[1]); w.y = cvt_pk_bf16(v0[2], v0[3]); w.z = cvt_pk_bf16(v1[0], v1[1]); w.w = cvt_pk_bf16(v1[2], v1[3]);
                        *(u32x4*)(rowp + bj * HALF) = w; }
                }
        }
    }
};
template <bool ADD> struct EpiGate {
    static constexpr bool PERM = true, AFTER_DRAIN = false;
    const bf16_t* gate; int ldg; bf16_t* O; int ldc;
    __device__ __forceinline__ void operator()(const f32x4 (&acc)[2][2][4][2], const Unit& u, int wr, int wc, int fr, int fq) const {
        const int row0 = u.pm * BM + wr * 64 + fr, col0 = u.pn * BM + wc * 32 + 8 * fq;
#pragma unroll
        for (int ai = 0; ai < 2; ++ai)
#pragma unroll
            for (int m = 0; m < 4; ++m) {
                const int row = row0 + ai * HALF + m * 16;
#pragma unroll
                for (int bj = 0; bj < 2; ++bj) {
                    const u32x4 g = *(const u32x4*)(gate + (size_t)row * ldg + col0 + bj * HALF);
                    bf16_t* op = O + (size_t)row * ldc + col0 + bj * HALF;
                    f32x4 v0 = acc[ai][bj][m][0], v1 = acc[ai][bj][m][1];
                    v0[0] *= sigm(bf_lo(g.x)); v0[1] *= sigm(bf_hi(g.x)); v0[2] *= sigm(bf_lo(g.y)); v0[3] *= sigm(bf_hi(g.y));
                    v1[0] *= sigm(bf_lo(g.z)); v1[1] *= sigm(bf_hi(g.z)); v1[2] *= sigm(bf_lo(g.w)); v1[3] *= sigm(bf_hi(g.w));
                    if (ADD) { const u32x4 t = *(const u32x4*)op;
                        v0[0] += bf_lo(t.x); v0[1] += bf_hi(t.x); v0[2] += bf_lo(t.y); v0[3] += bf_hi(t.y);
                        v1[0] += bf_lo(t.z); v1[1] += bf_hi(t.z); v1[2] += bf_lo(t.w); v1[3] += bf_hi(t.w); }
                    u32x4 w; w.x = cvt_pk_bf16(v0[0], v0[1]); w.y = cvt_pk_bf16(v0[2], v0[3]); w.z = cvt_pk_bf16(v1[0], v1[1]); w.w = cvt_pk_bf16(v1[2], v1[3]);
                    *(u32x4*)op = w; }
                asm volatile("" ::: "memory");
            }
    }
};
struct EpiSq {
    static constexpr bool PERM = true, AFTER_DRAIN = false;
    bf16_t* O; int ldc; float* part;
    __device__ __forceinline__ void operator()(const f32x4 (&acc)[2][2][4][2], const Unit& u, int wr, int wc, int fr, int fq) const {
        const int row0 = u.pm * BM + wr * 64 + fr, col0 = u.pn * BM + wc * 32 + 8 * fq;
#pragma unroll
        for (int ai = 0; ai < 2; ++ai)
#pragma unroll
            for (int m = 0; m < 4; ++m) {
                const int row = row0 + ai * HALF + m * 16; float s = 0.f;
#pragma unroll
                for (int bj = 0; bj < 2; ++bj) {
                    const f32x4 v0 = acc[ai][bj][m][0], v1 = acc[ai][bj][m][1];
                    s += (v0[0] * v0[0] + v0[1] * v0[1]) + (v0[2] * v0[2] + v0[3] * v0[3]) + (v1[0] * v1[0] + v1[1] * v1[1]) + (v1[2] * v1[2] + v1[3] * v1[3]);
                    u32x4 w; w.x = cvt_pk_bf16(v0[0], v0[1]); w.y = cvt_pk_bf16(v0[2], v0[3]); w.z = cvt_pk_bf16(v1[0], v1[1]); w.w = cvt_pk_bf16(v1[2], v1[3]);
                    *(u32x4*)(O + (size_t)row * ldc + col0 + bj * HALF) = w; }
                s += __shfl_xor(s, 16); s += __shfl_xor(s, 32);
                if (fq == 0) part[(size_t)row * 16 + u.pn * 4 + wc] = s;
            }
    }
};
struct EpiUp {
    static constexpr bool PERM = true, AFTER_DRAIN = false;
    bf16_t* O; int ldc; const float* rs;
    __device__ __forceinline__ void operator()(const f32x4 (&acc)[2][2][4][2], const Unit& u, int wr, int wc, int fr, int fq) const {
        const int row0 = u.pm * BM + wr * 64 + fr, col0 = u.pn * BM + wc * 32 + 8 * fq;
#pragma unroll
        for (int ai = 0; ai < 2; ++ai)
#pragma unroll
            for (int m = 0; m < 4; ++m) {
                const int row = row0 + ai * HALF + m * 16; const float s = rs[row];
#pragma unroll
                for (int bj = 0; bj < 2; ++bj) {
                    f32x4 v0 = acc[ai][bj][m][0] * s, v1 = acc[ai][bj][m][1] * s;
#pragma unroll
                    for (int j = 0; j < 4; ++j) { const float a = fmaxf(v0[j], 0.f), b = fmaxf(v1[j], 0.f); v0[j] = a * a; v1[j] = b * b; }
                    u32x4 w; w.x = cvt_pk_bf16(v0[0], v0[1]); w.y = cvt_pk_bf16(v0[2], v0[3]); w.z = cvt_pk_bf16(v1[0], v1[1]); w.w = cvt_pk_bf16(v1[2], v1[3]);
                    *(u32x4*)(O + (size_t)row * ldc + col0 + bj * HALF) = w; }
            }
    }
};

template <class Epi, class Sched, bool ALIGN_EPI = false, bool SP2 = false>
__device__ __forceinline__ void gemm_phase(PG8_LAS unsigned char* lds, const Gemm g, const Sched& S, const Epi& E) {
    int tid_ = threadIdx.x; asm volatile("" : "+v"(tid_));
    const int tid = tid_, wid = __builtin_amdgcn_readfirstlane(tid >> 6), lane = tid & 63, wr = wid >> 2, wc = wid & 3, fr = lane & 15, fq = lane >> 4;
    const int K = g.K, nt = K / BK;
    unsigned voffA[2], voffB[2];
#pragma unroll
    for (int i = 0; i < 2; ++i) { int R, C; stage_rc(tid * 16 + i * 8192, R, C); const int Rb = Epi::PERM ? ((R & ~31) + perm32(R & 31)) : R;
        voffA[i] = (unsigned)(R * K + C) * 2u; voffB[i] = (unsigned)(Rb * K + C) * 2u; }
    const size_t kstep = (size_t)(BK * 2);
    const size_t hstep = (size_t)HALF * K * 2;
    const size_t tstep = 2 * hstep;
    const unsigned ldsw = (unsigned)wid * 1024u;
    const int aoff = lds_byte(wr * 64 + fr, fq * 8), boff = lds_byte(wc * 32 + fr, fq * 8);
#define PG8_SA(b, h) (((b) * 2 + (h)) * HTB)
#define PG8_SB(b, h) ((4 + (b) * 2 + (h)) * HTB)
#define PG8_STAGE(bufoff, gbase, voff) do { _Pragma("unroll") for (int _i = 0; _i < 2; ++_i) \
        __builtin_amdgcn_global_load_lds((const unsigned*)((const char*)(gbase) + (voff)[_i]), (PG8_LAS unsigned*)(lds + (bufoff) + ldsw + _i * 8192), 16, 0, 0); } while (0)
#define PG8_LDA(dst, b, h) do { _Pragma("unroll") for (int m = 0; m < 4; ++m) _Pragma("unroll") for (int k = 0; k < 2; ++k) dst[m][k] = *(const PG8_LAS bf16x8*)(lds + PG8_SA(b, h) + aoff + m * 2048 + k * 1024); } while (0)
#define PG8_LDB(dst, b, h) do { _Pragma("unroll") for (int n = 0; n < 2; ++n) _Pragma("unroll") for (int k = 0; k < 2; ++k) dst[n][k] = *(const PG8_LAS bf16x8*)(lds + PG8_SB(b, h) + boff + n * 2048 + k * 1024); } while (0)
#define PG8_MMA(ai, bj, At, Bt) do { __builtin_amdgcn_s_setprio(1); _Pragma("unroll") for (int m = 0; m < 4; ++m) _Pragma("unroll") for (int n = 0; n < 2; ++n) _Pragma("unroll") for (int k = 0; k < 2; ++k) \
        acc[ai][bj][m][n] = __builtin_amdgcn_mfma_f32_16x16x32_bf16(Bt[n][k], At[m][k], acc[ai][bj][m][n], 0, 0, 0); __builtin_amdgcn_s_setprio(0); } while (0)
#define PG8_WAIT_V(n) asm volatile("s_waitcnt vmcnt(" #n ")" ::: "memory")
#define PG8_WAIT_L(n) asm volatile("s_waitcnt lgkmcnt(" #n ")" ::: "memory")
#define PG8_BAR __builtin_amdgcn_s_barrier()
#define PG8_SCHED __builtin_amdgcn_sched_barrier(0)
    Unit cur, nxt; int ui = 0;
    if (!S.next(0, cur)) return;
    f32x4 acc[2][2][4][2];
#pragma unroll
    for (int a = 0; a < 2; ++a)
#pragma unroll
        for (int b = 0; b < 2; ++b)
#pragma unroll
            for (int m = 0; m < 4; ++m)
#pragma unroll
                for (int n = 0; n < 2; ++n) acc[a][b][m][n] = (f32x4){0.f, 0.f, 0.f, 0.f};
    bf16x8 At[4][2], B0[2][2], B1[2][2];
    const char* cA = (const char*)g.A + (size_t)cur.pm * tstep; const char* cB = (const char*)g.Bt + (size_t)cur.pn * tstep;
    S.a_ready(cur);
    if constexpr (SP2) {
        PG8_STAGE(PG8_SB(0, 0), cB, voffB); PG8_STAGE(PG8_SB(0, 1), cB + hstep, voffB); PG8_STAGE(PG8_SA(0, 0), cA, voffA); PG8_STAGE(PG8_SA(0, 1), cA + hstep, voffA);
        if (wr == 1) PG8_BAR;
        PG8_WAIT_V(2); PG8_BAR;
        PG8_STAGE(PG8_SB(1, 0), cB + kstep, voffB); PG8_STAGE(PG8_SA(1, 0), cA + kstep, voffA); PG8_STAGE(PG8_SB(1, 1), cB + hstep + kstep, voffB);
        PG8_WAIT_V(6); PG8_BAR;
    } else {
        PG8_STAGE(PG8_SB(0, 0), cB, voffB); PG8_STAGE(PG8_SA(0, 0), cA, voffA); PG8_STAGE(PG8_SB(0, 1), cB + hstep, voffB); PG8_STAGE(PG8_SA(0, 1), cA + hstep, voffA);
        if (wr == 1) PG8_BAR;
        PG8_WAIT_V(4); PG8_BAR;
        PG8_STAGE(PG8_SB(1, 0), cB + kstep, voffB); PG8_STAGE(PG8_SA(1, 0), cA + kstep, voffA); PG8_STAGE(PG8_SB(1, 1), cB + hstep + kstep, voffB);
        PG8_WAIT_V(6); PG8_BAR;
    }
    for (;;) {
        const bool has_next = S.next(ui + 1, nxt);
        const char* nA = has_next ? (const char*)g.A + (size_t)nxt.pm * tstep : cA; const char* nB = has_next ? (const char*)g.Bt + (size_t)nxt.pn * tstep : cB;
#pragma clang loop unroll(disable)
        for (int t = 0; t < nt; t += 2) {
            const bool last = (t == nt - 2);
            const char* a1 = cA + (size_t)(t + 1) * kstep;
            const char* a2 = last ? nA : cA + (size_t)(t + 2) * kstep; const char* b2 = last ? nB : cB + (size_t)(t + 2) * kstep;
            const char* a3 = a2 + kstep; const char* b3 = b2 + kstep;
            if (last && has_next) S.a_ready(nxt);
            if constexpr (SP2) {
            PG8_LDB(B0, 0, 0); PG8_LDB(B1, 0, 1); PG8_SCHED; PG8_LDA(At, 0, 0); PG8_STAGE(PG8_SA(1, 1), a1 + hstep, voffA);
            PG8_WAIT_V(8); PG8_WAIT_L(0); PG8_BAR; PG8_MMA(0, 0, At, B0); PG8_MMA(0, 1, At, B1); PG8_BAR; PG8_SCHED;
            PG8_LDA(At, 0, 1); PG8_STAGE(PG8_SB(0, 0), b2, voffB); PG8_STAGE(PG8_SB(0, 1), b2 + hstep, voffB); PG8_STAGE(PG8_SA(0, 0), a2, voffA);
            PG8_WAIT_V(8); PG8_WAIT_L(0); PG8_BAR; PG8_MMA(1, 0, At, B0); PG8_MMA(1, 1, At, B1); PG8_BAR; PG8_SCHED;
            PG8_LDB(B0, 1, 0); PG8_LDB(B1, 1, 1); PG8_SCHED; PG8_LDA(At, 1, 0); PG8_STAGE(PG8_SA(0, 1), a2 + hstep, voffA);
            PG8_WAIT_V(8); PG8_WAIT_L(0); PG8_BAR; PG8_MMA(0, 0, At, B0); PG8_MMA(0, 1, At, B1); PG8_BAR; PG8_SCHED;
            PG8_LDA(At, 1, 1); PG8_STAGE(PG8_SB(1, 0), b3, voffB); PG8_STAGE(PG8_SB(1, 1), b3 + hstep, voffB); PG8_STAGE(PG8_SA(1, 0), a3, voffA);
            PG8_WAIT_V(8); PG8_WAIT_L(0); PG8_BAR; PG8_MMA(1, 0, At, B0); PG8_MMA(1, 1, At, B1); PG8_BAR; PG8_SCHED;
            } else {
            PG8_LDB(B0, 0, 0); PG8_SCHED; PG8_LDA(At, 0, 0); PG8_STAGE(PG8_SA(1, 1), a1 + hstep, voffA);
            PG8_WAIT_L(8); PG8_BAR; PG8_WAIT_L(0); PG8_MMA(0, 0, At, B0); PG8_BAR; PG8_SCHED;
            PG8_LDB(B1, 0, 1); PG8_STAGE(PG8_SB(0, 0), b2, voffB);
            PG8_BAR; PG8_WAIT_L(0); PG8_MMA(0, 1, At, B1); PG8_BAR;
            PG8_LDA(At, 0, 1); PG8_STAGE(PG8_SA(0, 0), a2, voffA);
            PG8_BAR; PG8_WAIT_L(0); PG8_MMA(1, 0, At, B0); PG8_BAR; PG8_SCHED;
            PG8_STAGE(PG8_SB(0, 1), b2 + hstep, voffB);
            PG8_WAIT_V(6); PG8_BAR; PG8_MMA(1, 1, At, B1); PG8_BAR;
            PG8_LDB(B0, 1, 0); PG8_SCHED; PG8_LDA(At, 1, 0); PG8_STAGE(PG8_SA(0, 1), a2 + hstep, voffA);
            PG8_WAIT_L(8); PG8_BAR; PG8_WAIT_L(0); PG8_MMA(0, 0, At, B0); PG8_BAR; PG8_SCHED;
            PG8_LDB(B1, 1, 1); PG8_STAGE(PG8_SB(1, 0), b3, voffB);
            PG8_BAR; PG8_WAIT_L(0); PG8_MMA(0, 1, At, B1); PG8_BAR;
            PG8_LDA(At, 1, 1); PG8_STAGE(PG8_SA(1, 0), a3, voffA);
            PG8_BAR; PG8_WAIT_L(0); PG8_MMA(1, 0, At, B0); PG8_BAR; PG8_SCHED;
            PG8_STAGE(PG8_SB(1, 1), b3 + hstep, voffB);
            PG8_WAIT_V(6); PG8_BAR; PG8_MMA(1, 1, At, B1); PG8_BAR;
            }
        }
        if constexpr (ALIGN_EPI) { if (wr == 0) PG8_BAR; }
        if constexpr (!Epi::AFTER_DRAIN) { E(acc, cur, wr, wc, fr, fq); S.done(cur); }
        if (!has_next) break;
#pragma unroll
        for (int a = 0; a < 2; ++a)
#pragma unroll
            for (int b = 0; b < 2; ++b)
#pragma unroll
                for (int m = 0; m < 4; ++m)
#pragma unroll
                    for (int n = 0; n < 2; ++n) acc[a][b][m][n] = (f32x4){0.f, 0.f, 0.f, 0.f};
        cur = nxt; cA = nA; cB = nB; ++ui;
        if constexpr (ALIGN_EPI) { if (wr == 1) PG8_BAR; }
    }
    PG8_WAIT_V(0);
    if constexpr (!ALIGN_EPI) { if (wr == 0) PG8_BAR; }
    PG8_BAR;
    if constexpr (Epi::AFTER_DRAIN) { E.fused(acc, cur, wr, wc, fr, fq, lds, wid, lane); S.done(cur); }
#undef PG8_SA
#undef PG8_SB
#undef PG8_STAGE
#undef PG8_LDA
#undef PG8_LDB
#undef PG8_MMA
#undef PG8_WAIT_V
#undef PG8_WAIT_L
#undef PG8_BAR
#undef PG8_SCHED
}
}

#define LAS __attribute__((address_space(3)))
typedef unsigned short bf16;
typedef unsigned v4u __attribute__((ext_vector_type(4)));
typedef unsigned v2u __attribute__((ext_vector_type(2)));
typedef float f32x4 __attribute__((ext_vector_type(4)));
typedef float f32x16 __attribute__((ext_vector_type(16)));
typedef short bf16x8 __attribute__((ext_vector_type(8)));
typedef short s16x4 __attribute__((ext_vector_type(4)));

constexpr int D = 1024, SEQ = 4096, NBATCH = 12, M = NBATCH * SEQ, INW = 7424, FF = 4096, DEPTH = 2, NPROMPT_ROWS = 8 * SEQ;
constexpr int CB = 4, MC = CB * SEQ, NCHUNK = NBATCH / CB;
constexpr int NWAVES = 8;
constexpr int LDS_BYTES = 147456;
constexpr float NORM_EPS = 1e-6f;
constexpr int ZQ = 0, ZK = 768, ZV = 1536, ZCB = 2304, ZCC = 3328, ZCH = 4352, ZGA = 5376, ZGC = 6400;

constexpr size_t WS_ROPE = 0;
constexpr size_t WS_RS = WS_ROPE + (size_t)SEQ * 32 * 8;
constexpr size_t WS_PART = WS_RS + (size_t)M * 4;
constexpr size_t WS_LSE = WS_PART + (size_t)MC * 16 * 4;
constexpr size_t WS_W = WS_LSE + (size_t)3 * MC * 4 * 4;
constexpr size_t LW_IN = 0, LW_A = LW_IN + (size_t)INW * D * 2, LW_C = LW_A + (size_t)D * 256 * 2, LW_O = LW_C + (size_t)D * D * 2,
                 LW_UP = LW_O + (size_t)D * D * 2, LW_DN = LW_UP + (size_t)FF * D * 2, LW_SIZE = LW_DN + (size_t)D * FF * 2;
constexpr size_t WS_XB = WS_W + DEPTH * LW_SIZE;
constexpr size_t WS_Z = WS_XB + (size_t)M * D * 2;
constexpr size_t WS_OG = WS_Z + (size_t)MC * INW * 2;
constexpr size_t WS_ATT = WS_OG + (size_t)3 * MC * 256 * 2;
constexpr size_t WS_RA = WS_ATT + (size_t)MC * 256 * 2;
constexpr size_t WS_RB = WS_RA + (size_t)MC * D * 2;
constexpr size_t WS_END = WS_RB + (size_t)MC * D * 2;
static_assert((size_t)MC * FF * 2 <= (size_t)MC * INW * 2, "H overlays Z");

__device__ __forceinline__ unsigned cvtpk(float lo, float hi) { unsigned r; asm volatile("v_cvt_pk_bf16_f32 %0, %1, %2" : "=v"(r) : "v"(lo), "v"(hi)); return r; }
__device__ __forceinline__ float blo(unsigned w) { return __uint_as_float(w << 16); }
__device__ __forceinline__ float bhi(unsigned w) { return __uint_as_float(w & 0xffff0000u); }
__device__ __forceinline__ float wave_sum(float v) {
#pragma unroll
    for (int o = 1; o < 64; o <<= 1) v += __shfl_xor(v, o);
    return v;
}
#define LDS_WAIT() asm volatile("s_waitcnt lgkmcnt(0)" ::: "memory")

struct Args { const float* in[13]; float* out; unsigned char* ws; };

__device__ __forceinline__ void p0_item(const float* W, int K, int N, bf16* WT, const float* gk, bool permqk, LAS float* scr, int item, int lane) {
    const int nblk = N / 32, kb = item / nblk, nb = item % nblk, k0 = 64 * kb, n0 = 32 * nb;
#pragma unroll 8
    for (int i = 0; i < 32; ++i) { const int kk = 2 * i + (lane >> 5); float w = W[(size_t)(k0 + kk) * N + n0 + (lane & 31)]; if (gk) w *= gk[k0 + kk]; scr[kk * 33 + (lane & 31)] = w; }
    LDS_WAIT(); asm volatile("" ::: "memory");
    const int c = lane & 7;
#pragma unroll
    for (int j = 0; j < 4; ++j) { const int n = (lane >> 3) + 8 * j; const LAS float* s = scr + (8 * c) * 33 + n;
        int nd = n0 + n;
        if (permqk && nd < 1536) { const int d = nd & 63; nd = (nd & ~63) + 8 * ((d & 31) >> 2) + 4 * (d >> 5) + (d & 3); }
        v4u o; o.x = cvtpk(s[0 * 33], s[1 * 33]); o.y = cvtpk(s[2 * 33], s[3 * 33]); o.z = cvtpk(s[4 * 33], s[5 * 33]); o.w = cvtpk(s[6 * 33], s[7 * 33]);
        *(v4u*)(WT + (size_t)nd * K + k0 + 8 * c) = o; }
    LDS_WAIT(); asm volatile("" ::: "memory");
}
__device__ __forceinline__ void sincos_d(double r, float& c, float& s) {
    const double r2 = r * r;
    double sp = 1.0 / 51090942171709440000.0;
    sp = sp * r2 - 1.0 / 121645100408832000.0; sp = sp * r2 + 1.0 / 355687428096000.0; sp = sp * r2 - 1.0 / 1307674368000.0; sp = sp * r2 + 1.0 / 6227020800.0;
    sp = sp * r2 - 1.0 / 39916800.0; sp = sp * r2 + 1.0 / 362880.0; sp = sp * r2 - 1.0 / 5040.0; sp = sp * r2 + 1.0 / 120.0; sp = sp * r2 - 1.0 / 6.0; sp = sp * r2 + 1.0;
    double cp = 1.0 / 1124000727777607680000.0;
    cp = cp * r2 - 1.0 / 2432902008176640000.0; cp = cp * r2 + 1.0 / 6402373705728000.0; cp = cp * r2 - 1.0 / 20922789888000.0; cp = cp * r2 + 1.0 / 87178291200.0;
    cp = cp * r2 - 1.0 / 479001600.0; cp = cp * r2 + 1.0 / 3628800.0; cp = cp * r2 - 1.0 / 40320.0; cp = cp * r2 + 1.0 / 720.0; cp = cp * r2 - 1.0 / 24.0; cp = cp * r2 + 0.5;
    s = (float)(sp * r); c = (float)(1.0 - cp * r2);
}
typedef const __attribute__((address_space(4))) Args* KArgs;
__device__ __forceinline__ void p0_prologue(KArgs ap, LAS unsigned char* lds, int blk, int G, int wave, int lane) {
    unsigned char* ws = ap->ws;
    LAS float* scr = (LAS float*)(lds + wave * 16384);
    const int gw = blk * NWAVES + wave, NGW = G * NWAVES;
    constexpr int I_IN = (D / 64) * (INW / 32), I_A = (256 / 64) * (D / 32), I_C = (D / 64) * (D / 32), I_O = I_C, I_UP = (D / 64) * (FF / 32), I_DN = (FF / 64) * (D / 32);
    constexpr int LAYER_ITEMS = I_IN + I_A + I_C + I_O + I_UP + I_DN;
    for (int it = gw; it < DEPTH * LAYER_ITEMS; it += NGW) {
        const int l = it / LAYER_ITEMS; int r = it % LAYER_ITEMS;
        unsigned char* wl = ws + WS_W + (size_t)l * LW_SIZE;
        if (r < I_IN) { p0_item(ap->in[6] + (size_t)l * D * INW, D, INW, (bf16*)(wl + LW_IN), ap->in[2] + l * D, true, scr, r, lane); continue; } r -= I_IN;
        if (r < I_A) { p0_item(ap->in[7] + (size_t)l * 256 * D, 256, D, (bf16*)(wl + LW_A), nullptr, false, scr, r, lane); continue; } r -= I_A;
        if (r < I_C) { p0_item(ap->in[9] + (size_t)l * D * D, D, D, (bf16*)(wl + LW_C), nullptr, false, scr, r, lane); continue; } r -= I_C;
        if (r < I_O) { p0_item(ap->in[10] + (size_t)l * D * D, D, D, (bf16*)(wl + LW_O), nullptr, false, scr, r, lane); continue; } r -= I_O;
        if (r < I_UP) { p0_item(ap->in[11] + (size_t)l * D * FF, D, FF, (bf16*)(wl + LW_UP), ap->in[4] + l * D, false, scr, r, lane); continue; } r -= I_UP;
        p0_item(ap->in[12] + (size_t)l * FF * D, FF, D, (bf16*)(wl + LW_DN), nullptr, false, scr, r, lane);
    }
    float* rope = (float*)(ws + WS_ROPE);
    for (int idx = blk * 512 + (int)threadIdx.x; idx < SEQ * 32; idx += G * 512) {
        const int pos = idx >> 5, i = idx & 31;
        const double inv = exp2(-(double)i * (13.287712379549449 / 32.0));
        const double ang = (double)pos * inv, k = rint(ang * 0.15915494309189535), r = ang - k * 6.283185307179586;
        float c, s; sincos_d(r, c, s); rope[2 * idx] = c; rope[2 * idx + 1] = s;
    }
    bf16* XB = (bf16*)(ws + WS_XB); float* RS = (float*)(ws + WS_RS);
    for (int row = gw; row < M; row += NGW) {
        const float* xr = row < NPROMPT_ROWS ? ap->in[0] + (size_t)row * D : ap->in[1] + (size_t)(row - NPROMPT_ROWS) * D;
        float ss = 0.f;
#pragma unroll
        for (int j = 0; j < 4; ++j) { const f32x4 v = *((const f32x4*)xr + lane + 64 * j); ss += (v[0] * v[0] + v[1] * v[1]) + (v[2] * v[2] + v[3] * v[3]);
            v2u o; o.x = cvtpk(v[0], v[1]); o.y = cvtpk(v[2], v[3]); *((v2u*)(XB + (size_t)row * D) + lane + 64 * j) = o; }
        ss = wave_sum(ss);
        if (lane == 0) RS[row] = 1.0f / sqrtf(ss * (1.0f / D) + NORM_EPS);
    }
}

__device__ __forceinline__ int crow(int r, int hi) { return (r & 3) + 8 * (r >> 2) + 4 * hi; }
__device__ __forceinline__ s16x4 vtr(const LAS unsigned char* p) { return __builtin_bit_cast(s16x4, __builtin_amdgcn_ds_read_tr16_b64_v4i16((LAS s16x4*)p)); }
__device__ __forceinline__ void attn_phase(LAS unsigned char* lds, const bf16* Zc, bf16* OG, float* LSE, int blk, int G, int wave, int lane) {
    constexpr int VST = 192;
    const int r32 = lane & 31, hi = lane >> 5;
    LAS unsigned char* vl = lds + wave * (32 * VST);
    const LAS unsigned char* vrd = vl + (4 * hi + ((lane & 15) >> 2)) * VST + ((lane >> 4) & 1) * 32 + (lane & 3) * 8;
    constexpr int NITEM = CB * 12 * 128;
    for (int item = blk * NWAVES + wave; item < NITEM; item += G * NWAVES) {
        const int sb = item & 127, gh = (item >> 7) % 12, bl = item / (128 * 12);
        const int g = gh >> 2, hh = gh & 3, sh = 2 * g, L = SEQ >> sh, nsb = 128 >> sh;
        const int c = sb / nsb, qb = sb % nsb, q0 = qb * 32;
        const size_t rowq = (size_t)bl * SEQ + ((size_t)(q0 + r32) << sh) + c;
        const bf16* qp = Zc + rowq * INW + ZQ + gh * 64 + 8 * hi;
        bf16x8 qf[4];
#pragma unroll
        for (int s = 0; s < 4; ++s) qf[s] = *(const bf16x8*)(qp + 16 * s);
        float m_run = -1e30f, l_run = 0.f; f32x16 o0, o1;
#pragma unroll
        for (int r = 0; r < 16; ++r) { o0[r] = 0.f; o1[r] = 0.f; }
        for (int t = 0; t < 5; ++t) {
            const int k0 = q0 - 64 + 32 * t; if (k0 < 0 || k0 >= L) continue;
            const size_t rowk = (size_t)bl * SEQ + ((size_t)(k0 + r32) << sh) + c;
            const bf16* kp = Zc + rowk * INW + ZK + gh * 64 + 8 * hi;
            bf16x8 kf[4];
#pragma unroll
            for (int s = 0; s < 4; ++s) kf[s] = *(const bf16x8*)(kp + 16 * s);
#pragma unroll
            for (int i = 0; i < 4; ++i) { const int id = lane + 64 * i, vr = id >> 3, ch = id & 7;
                const size_t rowv = (size_t)bl * SEQ + ((size_t)(k0 + vr) << sh) + c;
                const v4u v = *(const v4u*)(Zc + rowv * INW + ZV + gh * 64 + ch * 8);
                *(LAS v4u*)(vl + vr * VST + ch * 16) = v; }
            f32x16 p;
#pragma unroll
            for (int r = 0; r < 16; ++r) p[r] = 0.f;
#pragma unroll
            for (int s = 0; s < 4; ++s) p = __builtin_amdgcn_mfma_f32_32x32x16_bf16(kf[s], qf[s], p, 0, 0, 0);
            const int dq = q0 + r32 - k0;
            float mt = -1e30f;
#pragma unroll
            for (int r = 0; r < 16; ++r) { const int d = dq - crow(r, hi); const bool ok = (d <= 64) && (d >= -64); p[r] = ok ? p[r] : -1e30f; mt = fmaxf(mt, p[r]); }
            mt = fmaxf(mt, __shfl_xor(mt, 32));
            const float m_new = fmaxf(m_run, mt), alpha = __builtin_amdgcn_exp2f(m_run - m_new); m_run = m_new;
            float ls = 0.f;
#pragma unroll
            for (int r = 0; r < 16; ++r) { p[r] = __builtin_amdgcn_exp2f(p[r] - m_new); ls += p[r]; }
            l_run = l_run * alpha + ls;
#pragma unroll
            for (int r = 0; r < 16; ++r) { o0[r] *= alpha; o1[r] *= alpha; }
            v4u pw0, pw1;
            pw0.x = cvtpk(p[0], p[1]); pw0.y = cvtpk(p[2], p[3]); pw0.z = cvtpk(p[4], p[5]); pw0.w = cvtpk(p[6], p[7]);
            pw1.x = cvtpk(p[8], p[9]); pw1.y = cvtpk(p[10], p[11]); pw1.z = cvtpk(p[12], p[13]); pw1.w = cvtpk(p[14], p[15]);
            const bf16x8 pb0 = __builtin_bit_cast(bf16x8, pw0), pb1 = __builtin_bit_cast(bf16x8, pw1);
#pragma unroll
            for (int dt = 0; dt < 2; ++dt) {
#pragma unroll
                for (int s = 0; s < 2; ++s) {
                    const s16x4 lo = vtr(vrd + (16 * s) * VST + dt * 64), h8 = vtr(vrd + (16 * s + 8) * VST + dt * 64);
                    const bf16x8 af = (bf16x8){lo[0], lo[1], lo[2], lo[3], h8[0], h8[1], h8[2], h8[3]};
                    if (dt == 0) o0 = __builtin_amdgcn_mfma_f32_32x32x16_bf16(af, s == 0 ? pb0 : pb1, o0, 0, 0, 0);
                    else         o1 = __builtin_amdgcn_mfma_f32_32x32x16_bf16(af, s == 0 ? pb0 : pb1, o1, 0, 0, 0);
                }
            }
        }
        const float l_tot = l_run + __shfl_xor(l_run, 32), inv = 1.0f / l_tot;
        bf16* op = OG + ((size_t)g * MC + rowq) * 256 + hh * 64 + 4 * hi;
#pragma unroll
        for (int k = 0; k < 4; ++k) {
            v2u w0, w1;
            w0.x = cvtpk(o0[4 * k] * inv, o0[4 * k + 1] * inv); w0.y = cvtpk(o0[4 * k + 2] * inv, o0[4 * k + 3] * inv);
            w1.x = cvtpk(o1[4 * k] * inv, o1[4 * k + 1] * inv); w1.y = cvtpk(o1[4 * k + 2] * inv, o1[4 * k + 3] * inv);
            *(v2u*)(op + 8 * k) = w0; *(v2u*)(op + 32 + 8 * k) = w1;
        }
        if (hi == 0) LSE[((size_t)g * MC + rowq) * 4 + hh] = m_run + __builtin_amdgcn_logf(l_tot);
    }
}

__device__ __forceinline__ void loadu(const bf16* Zc, int row, int col, float (&u)[8]) {
    const v4u cc = *(const v4u*)(Zc + (size_t)row * INW + ZCC + col), hh = *(const v4u*)(Zc + (size_t)row * INW + ZCH + col);
    u[0] = blo(cc.x) * blo(hh.x); u[1] = bhi(cc.x) * bhi(hh.x); u[2] = blo(cc.y) * blo(hh.y); u[3] = bhi(cc.y) * bhi(hh.y);
    u[4] = blo(cc.z) * blo(hh.z); u[5] = bhi(cc.z) * bhi(hh.z); u[6] = blo(cc.w) * blo(hh.w); u[7] = bhi(cc.w) * bhi(hh.w);
}
__device__ __forceinline__ void combine_conv_phase(const bf16* Zc, const bf16* OG, const float* LSE, bf16* ATT, bf16* CBUF, const float* convw, int blk, int G) {
    int tid_ = threadIdx.x; asm volatile("" : "+v"(tid_));
    const int gt = blk * 512 + tid_, NT = G * 512;
    for (int idx = gt; idx < MC * 32; idx += NT) {
        const int row = idx >> 5, c8 = idx & 31, hh = c8 >> 3;
        const float l0 = LSE[((size_t)0 * MC + row) * 4 + hh], l1 = LSE[((size_t)1 * MC + row) * 4 + hh], l2 = LSE[((size_t)2 * MC + row) * 4 + hh];
        const float mx = fmaxf(l0, fmaxf(l1, l2));
        float w0 = __builtin_amdgcn_exp2f(l0 - mx), w1 = __builtin_amdgcn_exp2f(l1 - mx), w2 = __builtin_amdgcn_exp2f(l2 - mx);
        const float inv = 1.0f / (w0 + w1 + w2); w0 *= inv; w1 *= inv; w2 *= inv;
        const v4u a = *(const v4u*)(OG + ((size_t)0 * MC + row) * 256 + c8 * 8), b = *(const v4u*)(OG + ((size_t)1 * MC + row) * 256 + c8 * 8), c = *(const v4u*)(OG + ((size_t)2 * MC + row) * 256 + c8 * 8);
        v4u o;
        o.x = cvtpk(w0 * blo(a.x) + w1 * blo(b.x) + w2 * blo(c.x), w0 * bhi(a.x) + w1 * bhi(b.x) + w2 * bhi(c.x));
        o.y = cvtpk(w0 * blo(a.y) + w1 * blo(b.y) + w2 * blo(c.y), w0 * bhi(a.y) + w1 * bhi(b.y) + w2 * bhi(c.y));
        o.z = cvtpk(w0 * blo(a.z) + w1 * blo(b.z) + w2 * blo(c.z), w0 * bhi(a.z) + w1 * bhi(b.z) + w2 * bhi(c.z));
        o.w = cvtpk(w0 * blo(a.w) + w1 * blo(b.w) + w2 * blo(c.w), w0 * bhi(a.w) + w1 * bhi(b.w) + w2 * bhi(c.w));
        *(v4u*)(ATT + (size_t)row * 256 + c8 * 8) = o;
    }
    for (int idx = gt; idx < (MC / 16) * 128; idx += NT) {
        const int cg8 = idx & 127, rb = idx >> 7, col = cg8 * 8, t0 = rb * 16;
        float k0[8], k1[8], k2[8];
#pragma unroll
        for (int j = 0; j < 8; ++j) { k0[j] = convw[col + j]; k1[j] = convw[D + col + j]; k2[j] = convw[2 * D + col + j]; }
        float up[8], uc[8], un[8];
        if ((t0 & (SEQ - 1)) == 0) {
#pragma unroll
            for (int j = 0; j < 8; ++j) up[j] = 0.f;
        } else loadu(Zc, t0 - 1, col, up);
        loadu(Zc, t0, col, uc);
        for (int i = 0; i < 16; ++i) {
            const int row = t0 + i;
            if (((row + 1) & (SEQ - 1)) == 0) {
#pragma unroll
                for (int j = 0; j < 8; ++j) un[j] = 0.f;
            } else loadu(Zc, row + 1, col, un);
            const v4u bb = *(const v4u*)(Zc + (size_t)row * INW + ZCB + col);
            float cv[8];
#pragma unroll
            for (int j = 0; j < 8; ++j) cv[j] = up[j] * k0[j] + uc[j] * k1[j] + un[j] * k2[j];
            v4u o;
            o.x = cvtpk(blo(bb.x) * cv[0], bhi(bb.x) * cv[1]); o.y = cvtpk(blo(bb.y) * cv[2], bhi(bb.y) * cv[3]);
            o.z = cvtpk(blo(bb.z) * cv[4], bhi(bb.z) * cv[5]); o.w = cvtpk(blo(bb.w) * cv[6], bhi(bb.w) * cv[7]);
            *(v4u*)(CBUF + (size_t)row * D + col) = o;
#pragma unroll
            for (int j = 0; j < 8; ++j) { up[j] = uc[j]; uc[j] = un[j]; }
        }
    }
}

__device__ __forceinline__ void resid_norm_phase(const float* xi_a, const float* xi_b, int rowbase, const bf16* Y, const float* PART, const float* g, float* xo, bf16* XBc, float* RSc,
                                                 int blk, int G, int wave, int lane) {
    for (int lr = blk * NWAVES + wave; lr < MC; lr += G * NWAVES) {
        const int row = rowbase + lr;
        const f32x4* pp = (const f32x4*)(PART + (size_t)lr * 16);
        const f32x4 p0 = pp[0], p1 = pp[1], p2 = pp[2], p3 = pp[3];
        const float ssy = ((p0[0] + p0[1]) + (p0[2] + p0[3])) + ((p1[0] + p1[1]) + (p1[2] + p1[3])) + ((p2[0] + p2[1]) + (p2[2] + p2[3])) + ((p3[0] + p3[1]) + (p3[2] + p3[3]));
        const float rsy = 1.0f / sqrtf(ssy * (1.0f / D) + NORM_EPS);
        const float* xr = row < NPROMPT_ROWS ? xi_a + (size_t)row * D : xi_b + (size_t)(row - NPROMPT_ROWS) * D;
        float ss = 0.f;
#pragma unroll
        for (int j = 0; j < 4; ++j) {
            const f32x4 xv = *((const f32x4*)xr + lane + 64 * j), gv = *((const f32x4*)g + lane + 64 * j);
            const v2u yv = *((const v2u*)(Y + (size_t)lr * D) + lane + 64 * j);
            f32x4 o;
            o[0] = xv[0] + blo(yv.x) * rsy * gv[0]; o[1] = xv[1] + bhi(yv.x) * rsy * gv[1]; o[2] = xv[2] + blo(yv.y) * rsy * gv[2]; o[3] = xv[3] + bhi(yv.y) * rsy * gv[3];
            ss += (o[0] * o[0] + o[1] * o[1]) + (o[2] * o[2] + o[3] * o[3]);
            *((f32x4*)(xo + (size_t)row * D) + lane + 64 * j) = o;
            v2u w; w.x = cvtpk(o[0], o[1]); w.y = cvtpk(o[2], o[3]); *((v2u*)(XBc + (size_t)lr * D) + lane + 64 * j) = w;
        }
        ss = wave_sum(ss);
        if (lane == 0) RSc[lr] = 1.0f / sqrtf(ss * (1.0f / D) + NORM_EPS);
    }
}

__device__ __forceinline__ KArgs kargs() { auto p = __builtin_amdgcn_kernarg_segment_ptr(); asm volatile("" : "+s"(p)); return (KArgs)p; }
#ifndef PHM
#define PHM 0xFFFF
#endif
__global__ void __launch_bounds__(NWAVES * 64, 2) fwd_megakernel(Args a_unused) {
    extern __shared__ __attribute__((aligned(16))) unsigned char lds_raw[];
    cg::grid_group grid = cg::this_grid();
    LAS unsigned char* lds = (LAS unsigned char*)lds_raw;
#define WAVE_LANE int tid_ = threadIdx.x; asm volatile("" : "+v"(tid_)); const int lane = tid_ & 63, wave = __builtin_amdgcn_readfirstlane(tid_ >> 6)
#define BLK_G int blk = blockIdx.x, G = gridDim.x; asm volatile("" : "+s"(blk), "+s"(G))
#define WPTR(l, off) ((const bf16*)(ws + WS_W + (size_t)(l) * LW_SIZE + (off)))
    if constexpr ((PHM & 1) != 0) { WAVE_LANE; BLK_G; KArgs a = kargs(); p0_prologue(a, lds, blk, G, wave, lane); }
    grid.sync();

    for (int l = 0; l < DEPTH; ++l) {
        for (int ch = 0; ch < NCHUNK; ++ch) {
            if constexpr ((PHM & 2) != 0) {
                BLK_G; KArgs A = kargs(); unsigned char* ws = A->ws; const int rowbase = ch * MC;
                pg8::Gemm g{(const bf16*)(ws + WS_XB) + (size_t)rowbase * D, WPTR(l, LW_IN), MC, INW, D}; pg8::StaticOrder S; S.init(MC, INW, G, blk);
                pg8::EpiIn E{(bf16*)(ws + WS_Z), (const float*)(ws + WS_RS) + rowbase, (const float*)(ws + WS_ROPE), INW};
                pg8::gemm_phase<pg8::EpiIn, pg8::StaticOrder, true, true>(lds, g, S, E);
            }
            grid.sync();
            if constexpr ((PHM & 4) != 0) { WAVE_LANE; BLK_G; KArgs A = kargs(); unsigned char* ws = A->ws;
                attn_phase(lds, (const bf16*)(ws + WS_Z), (bf16*)(ws + WS_OG), (float*)(ws + WS_LSE), blk, G, wave, lane); }
            grid.sync();
            if constexpr ((PHM & 8) != 0) { BLK_G; KArgs A = kargs(); unsigned char* ws = A->ws;
                combine_conv_phase((const bf16*)(ws + WS_Z), (const bf16*)(ws + WS_OG), (const float*)(ws + WS_LSE), (bf16*)(ws + WS_ATT), (bf16*)(ws + WS_RA), A->in[8] + (size_t)l * 3 * D, blk, G); }
            grid.sync();
            if constexpr ((PHM & 16) != 0) {
                BLK_G; KArgs A = kargs(); unsigned char* ws = A->ws;
                pg8::Gemm g{(const bf16*)(ws + WS_ATT), WPTR(l, LW_A), MC, D, 256}; pg8::StaticOrder S; S.init(MC, D, G, blk);
                pg8::EpiGate<false> E{(const bf16*)(ws + WS_Z) + ZGA, INW, (bf16*)(ws + WS_RB), D};
                pg8::gemm_phase<pg8::EpiGate<false>, pg8::StaticOrder, true, true>(lds, g, S, E);
            }
            if constexpr ((PHM & 32) != 0) {
                BLK_G; KArgs A = kargs(); unsigned char* ws = A->ws;
                pg8::Gemm g{(const bf16*)(ws + WS_RA), WPTR(l, LW_C), MC, D, D}; pg8::StaticOrder S; S.init(MC, D, G, blk);
                pg8::EpiGate<true> E{(const bf16*)(ws + WS_Z) + ZGC, INW, (bf16*)(ws + WS_RB), D};
                pg8::gemm_phase<pg8::EpiGate<true>, pg8::StaticOrder, true, true>(lds, g, S, E);
            }
            grid.sync();
            if constexpr ((PHM & 64) != 0) {
                BLK_G; KArgs A = kargs(); unsigned char* ws = A->ws;
                pg8::Gemm g{(const bf16*)(ws + WS_RB), WPTR(l, LW_O), MC, D, D}; pg8::StaticOrder S; S.init(MC, D, G, blk);
                pg8::EpiSq E{(bf16*)(ws + WS_RA), D, (float*)(ws + WS_PART)};
                pg8::gemm_phase<pg8::EpiSq, pg8::StaticOrder, true, true>(lds, g, S, E);
            }
            grid.sync();
            if constexpr ((PHM & 128) != 0) { WAVE_LANE; BLK_G; KArgs A = kargs(); unsigned char* ws = A->ws; const int rowbase = ch * MC; float* out = A->out;
                const float* xa = l == 0 ? A->in[0] : out; const float* xb = l == 0 ? A->in[1] : out + (size_t)NPROMPT_ROWS * D;
                resid_norm_phase(xa, xb, rowbase, (const bf16*)(ws + WS_RA), (const float*)(ws + WS_PART), A->in[3] + l * D, out, (bf16*)(ws + WS_XB) + (size_t)rowbase * D, (float*)(ws + WS_RS) + rowbase,
                                 blk, G, wave, lane); }
            grid.sync();
            if constexpr ((PHM & 256) != 0) {
                BLK_G; KArgs A = kargs(); unsigned char* ws = A->ws; const int rowbase = ch * MC;
                pg8::Gemm g{(const bf16*)(ws + WS_XB) + (size_t)rowbase * D, WPTR(l, LW_UP), MC, FF, D}; pg8::StaticOrder S; S.init(MC, FF, G, blk);
                pg8::EpiUp E{(bf16*)(ws + WS_Z), FF, (const float*)(ws + WS_RS) + rowbase};
                pg8::gemm_phase<pg8::EpiUp, pg8::StaticOrder, true, true>(lds, g, S, E);
            }
            grid.sync();
            if constexpr ((PHM & 512) != 0) {
                BLK_G; KArgs A = kargs(); unsigned char* ws = A->ws;
                pg8::Gemm g{(const bf16*)(ws + WS_Z), WPTR(l, LW_DN), MC, D, FF}; pg8::StaticOrder S; S.init(MC, D, G, blk);
                pg8::EpiSq E{(bf16*)(ws + WS_RA), D, (float*)(ws + WS_PART)};
                pg8::gemm_phase<pg8::EpiSq, pg8::StaticOrder, true, true>(lds, g, S, E);
            }
            grid.sync();
            if constexpr ((PHM & 1024) != 0) { WAVE_LANE; BLK_G; KArgs A = kargs(); unsigned char* ws = A->ws; const int rowbase = ch * MC; float* out = A->out;
                resid_norm_phase(out, out + (size_t)NPROMPT_ROWS * D, rowbase, (const bf16*)(ws + WS_RA), (const float*)(ws + WS_PART), A->in[5] + l * D, out, (bf16*)(ws + WS_XB) + (size_t)rowbase * D, (float*)(ws + WS_RS) + rowbase,
                                 blk, G, wave, lane); }
        }
    }
}

extern "C" void kernel_launch(void* const* d_in, const int* in_sizes, int n_in, void* d_out, int out_size, void* d_ws, size_t ws_size, hipStream_t stream) {
    static int grid = 0;
    if (grid == 0) {
        if (n_in != 13 || out_size != M * D || ws_size < WS_END) { fprintf(stderr, "kernel_launch: unexpected shapes / workspace (%d inputs, out %d, ws %zu < %zu)\n", n_in, out_size, ws_size, (size_t)WS_END); grid = -1; return; }
        int dev = 0, cus = 0, per_cu = 0;
        (void)hipGetDevice(&dev); (void)hipDeviceGetAttribute(&cus, hipDeviceAttributeMultiprocessorCount, dev);
        (void)hipFuncSetAttribute((const void*)fwd_megakernel, hipFuncAttributeMaxDynamicSharedMemorySize, LDS_BYTES);
        if (hipOccupancyMaxActiveBlocksPerMultiprocessor(&per_cu, (const void*)fwd_megakernel, NWAVES * 64, LDS_BYTES) != hipSuccess || per_cu < 1) per_cu = 1;
        (void)hipGetLastError();
        grid = cus * per_cu;
        if (grid <= 0) grid = 256;
    }
    if (grid < 0) return;
    Args a{};
    for (int i = 0; i < 13; ++i) a.in[i] = (const float*)d_in[i];
    a.out = (float*)d_out; a.ws = (unsigned char*)d_ws;
    void* args[] = {&a};
    hipError_t e = hipLaunchCooperativeKernel((const void*)fwd_megakernel, dim3(grid), dim3(NWAVES * 64), args, LDS_BYTES, stream);
    if (e != hipSuccess) fprintf(stderr, "cooperative launch failed: %s (grid %d)\n", hipGetErrorString(e), grid);
}
```

```cpp
#include <hip/hip_runtime.h>
#include <hip/hip_cooperative_groups.h>
#include <cstdio>
#include <cstdint>
namespace cg = cooperative_groups;
namespace pg8 {
#define PG8_LAS __attribute__((address_space(3)))
typedef unsigned short bf16_t;
typedef short bf16x8 __attribute__((ext_vector_type(8)));
typedef float f32x4 __attribute__((ext_vector_type(4)));
typedef unsigned u32x4 __attribute__((ext_vector_type(4)));
constexpr int BM = 256, BK = 64, HALF = 128, HTB = HALF * BK * 2  , STAGE_BYTES = 8 * HTB, NXCD = 8, WGM = 8;

__host__ __device__ __forceinline__ int lds_byte(int r, int c) { const int st = (r >> 4) * 2 + (c >> 5), rr = r & 15, cc = c & 31, ob = rr * 64 + cc * 2; return st * 1024 + (ob ^ (((ob >> 9) & 1) << 5)); }
__host__ __device__ __forceinline__ void stage_rc(int b, int& R, int& C) { const int st = b / 1024, sb = b % 1024, swz = sb ^ (((sb >> 9) & 1) << 5); R = (st >> 1) * 16 + swz / 64; C = (st & 1) * 32 + (swz % 64) / 2; }
__host__ __device__ __forceinline__ int perm32(int rho) { const int n = rho >> 4, i = rho & 15; return 8 * (i >> 2) + 4 * n + (i & 3); }

struct Unit { int pm, pn; };
struct Gemm { const bf16_t* A; const bf16_t* Bt; int M, N, K; };

struct StaticOrder {
    int nM, nN, nwg, G, c;
    __host__ __device__ void init(int M, int N, int G_, int c_) { nM = M / BM; nN = N / BM; nwg = nM * nN; G = G_; c = c_; }
    __host__ __device__ bool next(int i, Unit& u) const {
        const long L = (long)i * G + c; if (L >= nwg) return false;
        int wgid = (int)L; { const int q = nwg / NXCD, r = nwg % NXCD, xcd = wgid % NXCD, off = wgid / NXCD; wgid = (xcd < r ? xcd * (q + 1) : r * (q + 1) + (xcd - r) * q) + off; }
        const int nig = WGM * nN, gid = wgid / nig, fm = gid * WGM, gsz = (nM - fm) < WGM ? (nM - fm) : WGM;
        u.pm = fm + ((wgid % nig) % gsz); u.pn = (wgid % nig) / gsz; return true;
    }
    __device__ __forceinline__ void a_ready(const Unit&) const {}
    __device__ __forceinline__ void done(const Unit&) const {}
};

__device__ __forceinline__ unsigned cvt_pk_bf16(float lo, float hi) { unsigned r; asm volatile("v_cvt_pk_bf16_f32 %0, %1, %2" : "=v"(r) : "v"(lo), "v"(hi)); return r; }
__device__ __forceinline__ float bf_lo(unsigned w) { return __uint_as_float(w << 16); }
__device__ __forceinline__ float bf_hi(unsigned w) { return __uint_as_float(w & 0xffff0000u); }
__device__ __forceinline__ float sigm(float x) { return __builtin_amdgcn_rcpf(1.0f + __builtin_amdgcn_exp2f(-1.4426950408889634f * x)); }
constexpr float QSCALE = 0.125f * 1.4426950408889634f;

struct EpiIn {
    static constexpr bool PERM = true, AFTER_DRAIN = false;
    bf16_t* Z; const float* rs; const float* rope; int ldc;
    __device__ __forceinline__ void operator()(const f32x4 (&acc)[2][2][4][2], const Unit& u, int wr, int wc, int fr, int fq) const {
        const int row0 = u.pm * BM + wr * 64 + fr, col0 = u.pn * BM + wc * 32 + 8 * fq;
        const int G = 4 * (wc & 1) + fq;
        if (u.pn < 6) {
            const float qs = u.pn < 3 ? QSCALE : 1.0f;
#pragma unroll
            for (int ai = 0; ai < 2; ++ai)
#pragma unroll
                for (int m = 0; m < 4; ++m) {
                    const int row = row0 + ai * HALF + m * 16; const float s = rs[row] * qs;
                    const f32x4* rp = (const f32x4*)(rope + ((size_t)(row & 4095) * 32 + 4 * G) * 2);
                    const f32x4 r0 = rp[0], r1 = rp[1];
                    const f32x4 cs = (f32x4){r0[0], r0[2], r1[0], r1[2]}, sn = (f32x4){r0[1], r0[3], r1[1], r1[3]};
                    bf16_t* rowp = Z + (size_t)row * ldc + col0;
#pragma unroll
                    for (int bj = 0; bj < 2; ++bj) {
                        const f32x4 lo = acc[ai][bj][m][0] * s, hi = acc[ai][bj][m][1] * s;
                        const f32x4 ol = lo * cs - hi * sn, oh = hi * cs + lo * sn;
                        u32x4 w; w.x = cvt_pk_bf16(ol[0], ol[1]); w.y = cvt_pk_bf16(ol[2], ol[3]); w.z = cvt_pk_bf16(oh[0], oh[1]); w.w = cvt_pk_bf16(oh[2], oh[3]);
                        *(u32x4*)(rowp + bj * HALF) = w; }
                }
        } else {
#pragma unroll
            for (int ai = 0; ai < 2; ++ai)
#pragma unroll
                for (int m = 0; m < 4; ++m) {
                    const int row = row0 + ai * HALF + m * 16; const float s = rs[row];
                    bf16_t* rowp = Z + (size_t)row * ldc + col0;
#pragma unroll
                    for (int bj = 0; bj < 2; ++bj) {
                        const f32x4 v0 = acc[ai][bj][m][0] * s, v1 = acc[ai][bj][m][1] * s;
                        u32x4 w; w.x = cvt_pk_bf16(v0[0], v0[1]); w.y = cvt_pk_bf16(v0[2], v0[3]); w.z = cvt_pk_bf16(v1[0], v1[1]); w.w = cvt_pk_bf16(v1[2], v1[3]);
                        *(u32x4*)(rowp + bj * HALF) = w; }
                }
        }
    }
};
template <bool ADD> struct EpiGate {
    static constexpr bool PERM = true, AFTER_DRAIN = false;
    const bf16_t* gate; int ldg; bf16_t* O; int ldc;
    __device__ __forceinline__ void operator()(const f32x4 (&acc)[2][2][4][2], const Unit& u, int wr, int wc, int fr, int fq) const {
        const int row0 = u.pm * BM + wr * 64 + fr, col0 = u.pn * BM + wc * 32 + 8 * fq;
#pragma unroll
        for (int ai = 0; ai < 2; ++ai)
#pragma unroll
            for (int m = 0; m < 4; ++m) {
                const int row = row0 + ai * HALF + m * 16;
#pragma unroll
                for (int bj = 0; bj < 2; ++bj) {
                    const u32x4 g = *(const u32x4*)(gate + (size_t)row * ldg + col0 + bj * HALF);
                    bf16_t* op = O + (size_t)row * ldc + col0 + bj * HALF;
                    f32x4 v0 = acc[ai][bj][m][0], v1 = acc[ai][bj][m][1];
                    v0[0] *= sigm(bf_lo(g.x)); v0[1] *= sigm(bf_hi(g.x)); v0[2] *= sigm(bf_lo(g.y)); v0[3] *= sigm(bf_hi(g.y));
                    v1[0] *= sigm(bf_lo(g.z)); v1[1] *= sigm(bf_hi(g.z)); v1[2] *= sigm(bf_lo(g.w)); v1[3] *= sigm(bf_hi(g.w));
                    if (ADD) { const u32x4 t = *(const u32x4*)op;
                        v0[0] += bf_lo(t.x); v0[1] += bf_hi(t.x); v0[2] += bf_lo(t.y); v0[3] += bf_hi(t.y);
                        v1[0] += bf_lo(t.z); v1[1] += bf_hi(t.z); v1[2] += bf_lo(t.w); v1[3] += bf_hi(t.w); }
                    u32x4 w; w.x = cvt_pk_bf16(v0[0], v0[1]); w.y = cvt_pk_bf16(v0[2], v0[3]); w.z = cvt_pk_bf16(v1[0], v1[1]); w.w = cvt_pk_bf16(v1[2], v1[3]);
                    *(u32x4*)op = w; }
                asm volatile("" ::: "memory");
            }
    }
};
struct EpiSq {
    static constexpr bool PERM = true, AFTER_DRAIN = false;
    bf16_t* O; int ldc; float* part;
    __device__ __forceinline__ void operator()(const f32x4 (&acc)[2][2][4][2], const Unit& u, int wr, int wc, int fr, int fq) const {
        const int row0 = u.pm * BM + wr * 64 + fr, col0 = u.pn * BM + wc * 32 + 8 * fq;
#pragma unroll
        for (int ai = 0; ai < 2; ++ai)
#pragma unroll
            for (int m = 0; m < 4; ++m) {
                const int row = row0 + ai * HALF + m * 16; float s = 0.f;
#pragma unroll
                for (int bj = 0; bj < 2; ++bj) {
                    const f32x4 v0 = acc[ai][bj][m][0], v1 = acc[ai][bj][m][1];
                    s += (v0[0] * v0[0] + v0[1] * v0[1]) + (v0[2] * v0[2] + v0[3] * v0[3]) + (v1[0] * v1[0] + v1[1] * v1[1]) + (v1[2] * v1[2] + v1[3] * v1[3]);
                    u32x4 w; w.x = cvt_pk_bf16(v0[0], v0[1]); w.y = cvt_pk_bf16(v0[2], v0[3]); w.z = cvt_pk_bf16(v1[0], v1[1]); w.w = cvt_pk_bf16(v1[2], v1[3]);
                    *(u32x4*)(O + (size_t)row * ldc + col0 + bj * HALF) = w; }
                s += __shfl_xor(s, 16); s += __shfl_xor(s, 32);
                if (fq == 0) part[(size_t)row * 16 + u.pn * 4 + wc] = s;
            }
    }
};
struct EpiUp {
    static constexpr bool PERM = true, AFTER_DRAIN = false;
    bf16_t* O; int ldc; const float* rs;
    __device__ __forceinline__ void operator()(const f32x4 (&acc)[2][2][4][2], const Unit& u, int wr, int wc, int fr, int fq) const {
        const int row0 = u.pm * BM + wr * 64 + fr, col0 = u.pn * BM + wc * 32 + 8 * fq;
#pragma unroll
        for (int ai = 0; ai < 2; ++ai)
#pragma unroll
            for (int m = 0; m < 4; ++m) {
                const int row = row0 + ai * HALF + m * 16; const float s = rs[row];
#pragma unroll
                for (int bj = 0; bj < 2; ++bj) {
                    f32x4 v0 = acc[ai][bj][m][0] * s, v1 = acc[ai][bj][m][1] * s;
#pragma unroll
                    for (int j = 0; j < 4; ++j) { const float a = fmaxf(v0[j], 0.f), b = fmaxf(v1[j], 0.f); v0[j] = a * a; v1[j] = b * b; }
                    u32x4 w; w.x = cvt_pk_bf16(v0[0], v0[1]); w.y = cvt_pk_bf16(v0[2], v0[3]); w.z = cvt_pk_bf16(v1[0], v1[1]); w.w = cvt_pk_bf16(v1[2], v1[3]);
                    *(u32x4*)(O + (size_t)row * ldc + col0 + bj * HALF) = w; }
            }
    }
};

template <class Epi, class Sched, bool ALIGN_EPI = false, bool SP2 = false>
__device__ __forceinline__ void gemm_phase(PG8_LAS unsigned char* lds, const Gemm g, const Sched& S, const Epi& E) {
    int tid_ = threadIdx.x; asm volatile("" : "+v"(tid_));
    const int tid = tid_, wid = __builtin_amdgcn_readfirstlane(tid >> 6), lane = tid & 63, wr = wid >> 2, wc = wid & 3, fr = lane & 15, fq = lane >> 4;
    const int K = g.K, nt = K / BK;
    unsigned voffA[2], voffB[2];
#pragma unroll
    for (int i = 0; i < 2; ++i) { int R, C; stage_rc(tid * 16 + i * 8192, R, C); const int Rb = Epi::PERM ? ((R & ~31) + perm32(R & 31)) : R;
        voffA[i] = (unsigned)(R * K + C) * 2u; voffB[i] = (unsigned)(Rb * K + C) * 2u; }
    const size_t kstep = (size_t)(BK * 2);
    const size_t hstep = (size_t)HALF * K * 2;
    const size_t tstep = 2 * hstep;
    const unsigned ldsw = (unsigned)wid * 1024u;
    const int aoff = lds_byte(wr * 64 + fr, fq * 8), boff = lds_byte(wc * 32 + fr, fq * 8);
#define PG8_SA(b, h) (((b) * 2 + (h)) * HTB)
#define PG8_SB(b, h) ((4 + (b) * 2 + (h)) * HTB)
#define PG8_STAGE(bufoff, gbase, voff) do { _Pragma("unroll") for (int _i = 0; _i < 2; ++_i) \
        __builtin_amdgcn_global_load_lds((const unsigned*)((const char*)(gbase) + (voff)[_i]), (PG8_LAS unsigned*)(lds + (bufoff) + ldsw + _i * 8192), 16, 0, 0); } while (0)
#define PG8_LDA(dst, b, h) do { _Pragma("unroll") for (int m = 0; m < 4; ++m) _Pragma("unroll") for (int k = 0; k < 2; ++k) dst[m][k] = *(const PG8_LAS bf16x8*)(lds + PG8_SA(b, h) + aoff + m * 2048 + k * 1024); } while (0)
#define PG8_LDB(dst, b, h) do { _Pragma("unroll") for (int n = 0; n < 2; ++n) _Pragma("unroll") for (int k = 0; k < 2; ++k) dst[n][k] = *(const PG8_LAS bf16x8*)(lds + PG8_SB(b, h) + boff + n * 2048 + k * 1024); } while (0)
#define PG8_MMA(ai, bj, At, Bt) do { __builtin_amdgcn_s_setprio(1); _Pragma("unroll") for (int m = 0; m < 4; ++m) _Pragma("unroll") for (int n = 0; n < 2; ++n) _Pragma("unroll") for (int k = 0; k < 2; ++k) \
        acc[ai][bj][m][n] = __builtin_amdgcn_mfma_f32_16x16x32_bf16(Bt[n][k], At[m][k], acc[ai][bj][m][n], 0, 0, 0); __builtin_amdgcn_s_setprio(0); } while (0)
#define PG8_WAIT_V(n) asm volatile("s_waitcnt vmcnt(" #n ")" ::: "memory")
#define PG8_WAIT_L(n) asm volatile("s_waitcnt lgkmcnt(" #n ")" ::: "memory")
#define PG8_BAR __builtin_amdgcn_s_barrier()
#define PG8_SCHED __builtin_amdgcn_sched_barrier(0)
    Unit cur, nxt; int ui = 0;
    if (!S.next(0, cur)) return;
    f32x4 acc[2][2][4][2];
#pragma unroll
    for (int a = 0; a < 2; ++a)
#pragma unroll
        for (int b = 0; b < 2; ++b)
#pragma unroll
            for (int m = 0; m < 4; ++m)
#pragma unroll
                for (int n = 0; n < 2; ++n) acc[a][b][m][n] = (f32x4){0.f, 0.f, 0.f, 0.f};
    bf16x8 At[4][2], B0[2][2], B1[2][2];
    const char* cA = (const char*)g.A + (size_t)cur.pm * tstep; const char* cB = (const char*)g.Bt + (size_t)cur.pn * tstep;
    S.a_ready(cur);
    if constexpr (SP2) {
        PG8_STAGE(PG8_SB(0, 0), cB, voffB); PG8_STAGE(PG8_SB(0, 1), cB + hstep, voffB); PG8_STAGE(PG8_SA(0, 0), cA, voffA); PG8_STAGE(PG8_SA(0, 1), cA + hstep, voffA);
        if (wr == 1) PG8_BAR;
        PG8_WAIT_V(2); PG8_BAR;
        PG8_STAGE(PG8_SB(1, 0), cB + kstep, voffB); PG8_STAGE(PG8_SA(1, 0), cA + kstep, voffA); PG8_STAGE(PG8_SB(1, 1), cB + hstep + kstep, voffB);
        PG8_WAIT_V(6); PG8_BAR;
    } else {
        PG8_STAGE(PG8_SB(0, 0), cB, voffB); PG8_STAGE(PG8_SA(0, 0), cA, voffA); PG8_STAGE(PG8_SB(0, 1), cB + hstep, voffB); PG8_STAGE(PG8_SA(0, 1), cA + hstep, voffA);
        if (wr == 1) PG8_BAR;
        PG8_WAIT_V(4); PG8_BAR;
        PG8_STAGE(PG8_SB(1, 0), cB + kstep, voffB); PG8_STAGE(PG8_SA(1, 0), cA + kstep, voffA); PG8_STAGE(PG8_SB(1, 1), cB + hstep + kstep, voffB);
        PG8_WAIT_V(6); PG8_BAR;
    }
    for (;;) {
        const bool has_next = S.next(ui + 1, nxt);
        const char* nA = has_next ? (const char*)g.A + (size_t)nxt.pm * tstep : cA; const char* nB = has_next ? (const char*)g.Bt + (size_t)nxt.pn * tstep : cB;
#pragma clang loop unroll(disable)
        for (int t = 0; t < nt; t += 2) {
            const bool last = (t == nt - 2);
            const char* a1 = cA + (size_t)(t + 1) * kstep;
            const char* a2 = last ? nA : cA + (size_t)(t + 2) * kstep; const char* b2 = last ? nB : cB + (size_t)(t + 2) * kstep;
            const char* a3 = a2 + kstep; const char* b3 = b2 + kstep;
            if (last && has_next) S.a_ready(nxt);
            if constexpr (SP2) {
            PG8_LDB(B0, 0, 0); PG8_LDB(B1, 0, 1); PG8_SCHED; PG8_LDA(At, 0, 0); PG8_STAGE(PG8_SA(1, 1), a1 + hstep, voffA);
            PG8_WAIT_V(8); PG8_WAIT_L(0); PG8_BAR; PG8_MMA(0, 0, At, B0); PG8_MMA(0, 1, At, B1); PG8_BAR; PG8_SCHED;
            PG8_LDA(At, 0, 1); PG8_STAGE(PG8_SB(0, 0), b2, voffB); PG8_STAGE(PG8_SB(0, 1), b2 + hstep, voffB); PG8_STAGE(PG8_SA(0, 0), a2, voffA);
            PG8_WAIT_V(8); PG8_WAIT_L(0); PG8_BAR; PG8_MMA(1, 0, At, B0); PG8_MMA(1, 1, At, B1); PG8_BAR; PG8_SCHED;
            PG8_LDB(B0, 1, 0); PG8_LDB(B1, 1, 1); PG8_SCHED; PG8_LDA(At, 1, 0); PG8_STAGE(PG8_SA(0, 1), a2 + hstep, voffA);
            PG8_WAIT_V(8); PG8_WAIT_L(0); PG8_BAR; PG8_MMA(0, 0, At, B0); PG8_MMA(0, 1, At, B1); PG8_BAR; PG8_SCHED;
            PG8_LDA(At, 1, 1); PG8_STAGE(PG8_SB(1, 0), b3, voffB); PG8_STAGE(PG8_SB(1, 1), b3 + hstep, voffB); PG8_STAGE(PG8_SA(1, 0), a3, voffA);
            PG8_WAIT_V(8); PG8_WAIT_L(0); PG8_BAR; PG8_MMA(1, 0, At, B0); PG8_MMA(1, 1, At, B1); PG8_BAR; PG8_SCHED;
            } else {
            PG8_LDB(B0, 0, 0); PG8_SCHED; PG8_LDA(At, 0, 0); PG8_STAGE(PG8_SA(1, 1), a1 + hstep, voffA);
            PG8_WAIT_L(8); PG8_BAR; PG8_WAIT_L(0); PG8_MMA(0, 0, At, B0); PG8_BAR; PG8_SCHED;
            PG8_LDB(B1, 0, 1); PG8_STAGE(PG8_SB(0, 0), b2, voffB);
            PG8_BAR; PG8_WAIT_L(0); PG8_MMA(0, 1, At, B1); PG8_BAR;
            PG8_LDA(At, 0, 1); PG8_STAGE(PG8_SA(0, 0), a2, voffA);
            PG8_BAR; PG8_WAIT_L(0); PG8_MMA(1, 0, At, B0); PG8_BAR; PG8_SCHED;
            PG8_STAGE(PG8_SB(0, 1), b2 + hstep, voffB);
            PG8_WAIT_V(6); PG8_BAR; PG8_MMA(1, 1, At, B1); PG8_BAR;
            PG8_LDB(B0, 1, 0); PG8_SCHED; PG8_LDA(At, 1, 0); PG8_STAGE(PG8_SA(0, 1), a2 + hstep, voffA);
            PG8_WAIT_L(8); PG8_BAR; PG8_WAIT_L(0); PG8_MMA(0, 0, At, B0); PG8_BAR; PG8_SCHED;
            PG8_LDB(B1, 1, 1); PG8_STAGE(PG8_SB(1, 0), b3, voffB);
            PG8_BAR; PG8_WAIT_L(0); PG8_MMA(0, 1, At, B1); PG8_BAR;
            PG8_LDA(At, 1, 1); PG8_STAGE(PG8_SA(1, 0), a3, voffA);
            PG8_BAR; PG8_WAIT_L(0); PG8_MMA(1, 0, At, B0); PG8_BAR; PG8_SCHED;
            PG8_STAGE(PG8_SB(1, 1), b3 + hstep, voffB);
            PG8_WAIT_V(6); PG8_BAR; PG8_MMA(1, 1, At, B1); PG8_BAR;
            }
        }
        if constexpr (ALIGN_EPI) { if (wr == 0) PG8_BAR; }
        if constexpr (!Epi::AFTER_DRAIN) { E(acc, cur, wr, wc, fr, fq); S.done(cur); }
        if (!has_next) break;
#pragma unroll
        for (int a = 0; a < 2; ++a)
#pragma unroll
            for (int b = 0; b < 2; ++b)
#pragma unroll
                for (int m = 0; m < 4; ++m)
#pragma unroll
                    for (int n = 0; n < 2; ++n) acc[a][b][m][n] = (f32x4){0.f, 0.f, 0.f, 0.f};
        cur = nxt; cA = nA; cB = nB; ++ui;
        if constexpr (ALIGN_EPI) { if (wr == 1) PG8_BAR; }
    }
    PG8_WAIT_V(0);
    if constexpr (!ALIGN_EPI) { if (wr == 0) PG8_BAR; }
    PG8_BAR;
    if constexpr (Epi::AFTER_DRAIN) { E.fused(acc, cur, wr, wc, fr, fq, lds, wid, lane); S.done(cur); }
#undef PG8_SA
#undef PG8_SB
#undef PG8_STAGE
#undef PG8_LDA
#undef PG8_LDB
#undef PG8_MMA
#undef PG8_WAIT_V
#undef PG8_WAIT_L
#undef PG8_BAR
#undef PG8_SCHED
}
}

#define LAS __attribute__((address_space(3)))
typedef unsigned short bf16;
typedef unsigned v4u __attribute__((ext_vector_type(4)));
typedef unsigned v2u __attribute__((ext_vector_type(2)));
typedef float f32x4 __attribute__((ext_vector_type(4)));
typedef float f32x16 __attribute__((ext_vector_type(16)));
typedef short bf16x8 __attribute__((ext_vector_type(8)));
typedef short s16x4 __attribute__((ext_vector_type(4)));

constexpr int D = 1024, SEQ = 4096, NBATCH = 12, M = NBATCH * SEQ, INW = 7424, FF = 4096, DEPTH = 2, NPROMPT_ROWS = 8 * SEQ;
constexpr int CB = 4, MC = CB * SEQ, NCHUNK = NBATCH / CB;
constexpr int NWAVES = 8;
constexpr int LDS_BYTES = 147456;
constexpr float NORM_EPS = 1e-6f;
constexpr int ZQ = 0, ZK = 768, ZV = 1536, ZCB = 2304, ZCC = 3328, ZCH = 4352, ZGA = 5376, ZGC = 6400;

constexpr size_t WS_ROPE = 0;
constexpr size_t WS_RS = WS_ROPE + (size_t)SEQ * 32 * 8;
constexpr size_t WS_PART = WS_RS + (size_t)M * 4;
constexpr size_t WS_LSE = WS_PART + (size_t)MC * 16 * 4;
constexpr size_t WS_W = WS_LSE + (size_t)3 * MC * 4 * 4;
constexpr size_t LW_IN = 0, LW_A = LW_IN + (size_t)INW * D * 2, LW_C = LW_A + (size_t)D * 256 * 2, LW_O = LW_C + (size_t)D * D * 2,
                 LW_UP = LW_O + (size_t)D * D * 2, LW_DN = LW_UP + (size_t)FF * D * 2, LW_SIZE = LW_DN + (size_t)D * FF * 2;
constexpr size_t WS_XB = WS_W + DEPTH * LW_SIZE;
constexpr size_t WS_Z = WS_XB + (size_t)M * D * 2;
constexpr size_t WS_OG = WS_Z + (size_t)MC * INW * 2;
constexpr size_t WS_ATT = WS_OG + (size_t)3 * MC * 256 * 2;
constexpr size_t WS_RA = WS_ATT + (size_t)MC * 256 * 2;
constexpr size_t WS_RB = WS_RA + (size_t)MC * D * 2;
constexpr size_t WS_BAR = WS_RB + (size_t)MC * D * 2;
constexpr size_t WS_END = WS_BAR + 16384;
static_assert((size_t)MC * FF * 2 <= (size_t)MC * INW * 2, "H overlays Z");

__device__ __forceinline__ unsigned cvtpk(float lo, float hi) { unsigned r; asm volatile("v_cvt_pk_bf16_f32 %0, %1, %2" : "=v"(r) : "v"(lo), "v"(hi)); return r; }
__device__ __forceinline__ float blo(unsigned w) { return __uint_as_float(w << 16); }
__device__ __forceinline__ float bhi(unsigned w) { return __uint_as_float(w & 0xffff0000u); }
__device__ __forceinline__ float wave_sum(float v) {
#pragma unroll
    for (int o = 1; o < 64; o <<= 1) v += __shfl_xor(v, o);
    return v;
}
#define LDS_WAIT() asm volatile("s_waitcnt lgkmcnt(0)" ::: "memory")

struct Args { const float* in[13]; float* out; unsigned char* ws; };

__device__ __forceinline__ void p0_item(const float* W, int K, int N, bf16* WT, const float* gk, bool permqk, LAS float* scr, int item, int lane) {
    const int nblk = N / 32, kb = item / nblk, nb = item % nblk, k0 = 64 * kb, n0 = 32 * nb;
#pragma unroll 8
    for (int i = 0; i < 32; ++i) { const int kk = 2 * i + (lane >> 5); float w = W[(size_t)(k0 + kk) * N + n0 + (lane & 31)]; if (gk) w *= gk[k0 + kk]; scr[kk * 33 + (lane & 31)] = w; }
    LDS_WAIT(); asm volatile("" ::: "memory");
    const int c = lane & 7;
#pragma unroll
    for (int j = 0; j < 4; ++j) { const int n = (lane >> 3) + 8 * j; const LAS float* s = scr + (8 * c) * 33 + n;
        int nd = n0 + n;
        if (permqk && nd < 1536) { const int d = nd & 63; nd = (nd & ~63) + 8 * ((d & 31) >> 2) + 4 * (d >> 5) + (d & 3); }
        v4u o; o.x = cvtpk(s[0 * 33], s[1 * 33]); o.y = cvtpk(s[2 * 33], s[3 * 33]); o.z = cvtpk(s[4 * 33], s[5 * 33]); o.w = cvtpk(s[6 * 33], s[7 * 33]);
        *(v4u*)(WT + (size_t)nd * K + k0 + 8 * c) = o; }
    LDS_WAIT(); asm volatile("" ::: "memory");
}
__device__ __forceinline__ void sincos_d(double r, float& c, float& s) {
    const double r2 = r * r;
    double sp = 1.0 / 51090942171709440000.0;
    sp = sp * r2 - 1.0 / 121645100408832000.0; sp = sp * r2 + 1.0 / 355687428096000.0; sp = sp * r2 - 1.0 / 1307674368000.0; sp = sp * r2 + 1.0 / 6227020800.0;
    sp = sp * r2 - 1.0 / 39916800.0; sp = sp * r2 + 1.0 / 362880.0; sp = sp * r2 - 1.0 / 5040.0; sp = sp * r2 + 1.0 / 120.0; sp = sp * r2 - 1.0 / 6.0; sp = sp * r2 + 1.0;
    double cp = 1.0 / 1124000727777607680000.0;
    cp = cp * r2 - 1.0 / 2432902008176640000.0; cp = cp * r2 + 1.0 / 6402373705728000.0; cp = cp * r2 - 1.0 / 20922789888000.0; cp = cp * r2 + 1.0 / 87178291200.0;
    cp = cp * r2 - 1.0 / 479001600.0; cp = cp * r2 + 1.0 / 3628800.0; cp = cp * r2 - 1.0 / 40320.0; cp = cp * r2 + 1.0 / 720.0; cp = cp * r2 - 1.0 / 24.0; cp = cp * r2 + 0.5;
    s = (float)(sp * r); c = (float)(1.0 - cp * r2);
}
typedef const __attribute__((address_space(4))) Args* KArgs;
__device__ __forceinline__ void p0_prologue(KArgs ap, LAS unsigned char* lds, int blk, int G, int wave, int lane) {
    unsigned char* ws = ap->ws;
    LAS float* scr = (LAS float*)(lds + wave * 16384);
    const int gw = blk * NWAVES + wave, NGW = G * NWAVES;
    constexpr int I_IN = (D / 64) * (INW / 32), I_A = (256 / 64) * (D / 32), I_C = (D / 64) * (D / 32), I_O = I_C, I_UP = (D / 64) * (FF / 32), I_DN = (FF / 64) * (D / 32);
    constexpr int LAYER_ITEMS = I_IN + I_A + I_C + I_O + I_UP + I_DN;
    for (int it = gw; it < DEPTH * LAYER_ITEMS; it += NGW) {
        const int l = it / LAYER_ITEMS; int r = it % LAYER_ITEMS;
        unsigned char* wl = ws + WS_W + (size_t)l * LW_SIZE;
        if (r < I_IN) { p0_item(ap->in[6] + (size_t)l * D * INW, D, INW, (bf16*)(wl + LW_IN), ap->in[2] + l * D, true, scr, r, lane); continue; } r -= I_IN;
        if (r < I_A) { p0_item(ap->in[7] + (size_t)l * 256 * D, 256, D, (bf16*)(wl + LW_A), nullptr, false, scr, r, lane); continue; } r -= I_A;
        if (r < I_C) { p0_item(ap->in[9] + (size_t)l * D * D, D, D, (bf16*)(wl + LW_C), nullptr, false, scr, r, lane); continue; } r -= I_C;
        if (r < I_O) { p0_item(ap->in[10] + (size_t)l * D * D, D, D, (bf16*)(wl + LW_O), nullptr, false, scr, r, lane); continue; } r -= I_O;
        if (r < I_UP) { p0_item(ap->in[11] + (size_t)l * D * FF, D, FF, (bf16*)(wl + LW_UP), ap->in[4] + l * D, false, scr, r, lane); continue; } r -= I_UP;
        p0_item(ap->in[12] + (size_t)l * FF * D, FF, D, (bf16*)(wl + LW_DN), nullptr, false, scr, r, lane);
    }
    float* rope = (float*)(ws + WS_ROPE);
    for (int idx = blk * 512 + (int)threadIdx.x; idx < SEQ * 32; idx += G * 512) {
        const int pos = idx >> 5, i = idx & 31;
        const double inv = exp2(-(double)i * (13.287712379549449 / 32.0));
        const double ang = (double)pos * inv, k = rint(ang * 0.15915494309189535), r = ang - k * 6.283185307179586;
        float c, s; sincos_d(r, c, s); rope[2 * idx] = c; rope[2 * idx + 1] = s;
    }
    bf16* XB = (bf16*)(ws + WS_XB); float* RS = (float*)(ws + WS_RS);
    for (int row = gw; row < M; row += NGW) {
        const float* xr = row < NPROMPT_ROWS ? ap->in[0] + (size_t)row * D : ap->in[1] + (size_t)(row - NPROMPT_ROWS) * D;
        float ss = 0.f;
#pragma unroll
        for (int j = 0; j < 4; ++j) { const f32x4 v = *((const f32x4*)xr + lane + 64 * j); ss += (v[0] * v[0] + v[1] * v[1]) + (v[2] * v[2] + v[3] * v[3]);
            v2u o; o.x = cvtpk(v[0], v[1]); o.y = cvtpk(v[2], v[3]); *((v2u*)(XB + (size_t)row * D) + lane + 64 * j) = o; }
        ss = wave_sum(ss);
        if (lane == 0) RS[row] = 1.0f / sqrtf(ss * (1.0f / D) + NORM_EPS);
    }
}

__device__ __forceinline__ int crow(int r, int hi) { return (r & 3) + 8 * (r >> 2) + 4 * hi; }
__device__ __forceinline__ s16x4 vtr(const LAS unsigned char* p) { return __builtin_bit_cast(s16x4, __builtin_amdgcn_ds_read_tr16_b64_v4i16((LAS s16x4*)p)); }
__device__ __forceinline__ void attn_phase(LAS unsigned char* lds, const bf16* Zc, bf16* OG, float* LSE, int blk, int G, int wave, int lane) {
    constexpr int VST = 192;
    const int r32 = lane & 31, hi = lane >> 5;
    LAS unsigned char* vl = lds + wave * (32 * VST);
    const LAS unsigned char* vrd = vl + (4 * hi + ((lane & 15) >> 2)) * VST + ((lane >> 4) & 1) * 32 + (lane & 3) * 8;
    constexpr int NITEM = CB * 12 * 128;
    for (int item = blk * NWAVES + wave; item < NITEM; item += G * NWAVES) {
        const int sb = item & 127, gh = (item >> 7) % 12, bl = item / (128 * 12);
        const int g = gh >> 2, hh = gh & 3, sh = 2 * g, L = SEQ >> sh, nsb = 128 >> sh;
        const int c = sb / nsb, qb = sb % nsb, q0 = qb * 32;
        const size_t rowq = (size_t)bl * SEQ + ((size_t)(q0 + r32) << sh) + c;
        const bf16* qp = Zc + rowq * INW + ZQ + gh * 64 + 8 * hi;
        bf16x8 qf[4];
#pragma unroll
        for (int s = 0; s < 4; ++s) qf[s] = *(const bf16x8*)(qp + 16 * s);
        float m_run = -1e30f, l_run = 0.f; f32x16 o0, o1;
#pragma unroll
        for (int r = 0; r < 16; ++r) { o0[r] = 0.f; o1[r] = 0.f; }
        for (int t = 0; t < 5; ++t) {
            const int k0 = q0 - 64 + 32 * t; if (k0 < 0 || k0 >= L) continue;
            const size_t rowk = (size_t)bl * SEQ + ((size_t)(k0 + r32) << sh) + c;
            const bf16* kp = Zc + rowk * INW + ZK + gh * 64 + 8 * hi;
            bf16x8 kf[4];
#pragma unroll
            for (int s = 0; s < 4; ++s) kf[s] = *(const bf16x8*)(kp + 16 * s);
#pragma unroll
            for (int i = 0; i < 4; ++i) { const int id = lane + 64 * i, vr = id >> 3, ch = id & 7;
                const size_t rowv = (size_t)bl * SEQ + ((size_t)(k0 + vr) << sh) + c;
                const v4u v = *(const v4u*)(Zc + rowv * INW + ZV + gh * 64 + ch * 8);
                *(LAS v4u*)(vl + vr * VST + ch * 16) = v; }
            f32x16 p;
#pragma unroll
            for (int r = 0; r < 16; ++r) p[r] = 0.f;
#pragma unroll
            for (int s = 0; s < 4; ++s) p = __builtin_amdgcn_mfma_f32_32x32x16_bf16(kf[s], qf[s], p, 0, 0, 0);
            const int dq = q0 + r32 - k0;
            float mt = -1e30f;
#pragma unroll
            for (int r = 0; r < 16; ++r) { const int d = dq - crow(r, hi); const bool ok = (d <= 64) && (d >= -64); p[r] = ok ? p[r] : -1e30f; mt = fmaxf(mt, p[r]); }
            mt = fmaxf(mt, __shfl_xor(mt, 32));
            const float m_new = fmaxf(m_run, mt), alpha = __builtin_amdgcn_exp2f(m_run - m_new); m_run = m_new;
            float ls = 0.f;
#pragma unroll
            for (int r = 0; r < 16; ++r) { p[r] = __builtin_amdgcn_exp2f(p[r] - m_new); ls += p[r]; }
            l_run = l_run * alpha + ls;
#pragma unroll
            for (int r = 0; r < 16; ++r) { o0[r] *= alpha; o1[r] *= alpha; }
            v4u pw0, pw1;
            pw0.x = cvtpk(p[0], p[1]); pw0.y = cvtpk(p[2], p[3]); pw0.z = cvtpk(p[4], p[5]); pw0.w = cvtpk(p[6], p[7]);
            pw1.x = cvtpk(p[8], p[9]); pw1.y = cvtpk(p[10], p[11]); pw1.z = cvtpk(p[12], p[13]); pw1.w = cvtpk(p[14], p[15]);
            const bf16x8 pb0 = __builtin_bit_cast(bf16x8, pw0), pb1 = __builtin_bit_cast(bf16x8, pw1);
#pragma unroll
            for (int dt = 0; dt < 2; ++dt) {
#pragma unroll
                for (int s = 0; s < 2; ++s) {
                    const s16x4 lo = vtr(vrd + (16 * s) * VST + dt * 64), h8 = vtr(vrd + (16 * s + 8) * VST + dt * 64);
                    const bf16x8 af = (bf16x8){lo[0], lo[1], lo[2], lo[3], h8[0], h8[1], h8[2], h8[3]};
                    if (dt == 0) o0 = __builtin_amdgcn_mfma_f32_32x32x16_bf16(af, s == 0 ? pb0 : pb1, o0, 0, 0, 0);
                    else         o1 = __builtin_amdgcn_mfma_f32_32x32x16_bf16(af, s == 0 ? pb0 : pb1, o1, 0, 0, 0);
                }
            }
        }
        const float l_tot = l_run + __shfl_xor(l_run, 32), inv = 1.0f / l_tot;
        bf16* op = OG + ((size_t)g * MC + rowq) * 256 + hh * 64 + 4 * hi;
#pragma unroll
        for (int k = 0; k < 4; ++k) {
            v2u w0, w1;
            w0.x = cvtpk(o0[4 * k] * inv, o0[4 * k + 1] * inv); w0.y = cvtpk(o0[4 * k + 2] * inv, o0[4 * k + 3] * inv);
            w1.x = cvtpk(o1[4 * k] * inv, o1[4 * k + 1] * inv); w1.y = cvtpk(o1[4 * k + 2] * inv, o1[4 * k + 3] * inv);
            *(v2u*)(op + 8 * k) = w0; *(v2u*)(op + 32 + 8 * k) = w1;
        }
        if (hi == 0) LSE[((size_t)g * MC + rowq) * 4 + hh] = m_run + __builtin_amdgcn_logf(l_tot);
    }
}

__device__ __forceinline__ void loadu(const bf16* Zc, int row, int col, float (&u)[8]) {
    const v4u cc = *(const v4u*)(Zc + (size_t)row * INW + ZCC + col), hh = *(const v4u*)(Zc + (size_t)row * INW + ZCH + col);
    u[0] = blo(cc.x) * blo(hh.x); u[1] = bhi(cc.x) * bhi(hh.x); u[2] = blo(cc.y) * blo(hh.y); u[3] = bhi(cc.y) * bhi(hh.y);
    u[4] = blo(cc.z) * blo(hh.z); u[5] = bhi(cc.z) * bhi(hh.z); u[6] = blo(cc.w) * blo(hh.w); u[7] = bhi(cc.w) * bhi(hh.w);
}
__device__ __forceinline__ void combine_conv_phase(const bf16* Zc, const bf16* OG, const float* LSE, bf16* ATT, bf16* CBUF, const float* convw, int blk, int G) {
    int tid_ = threadIdx.x; asm volatile("" : "+v"(tid_));
    const int gt = blk * 512 + tid_, NT = G * 512;
    for (int idx = gt; idx < MC * 32; idx += NT) {
        const int row = idx >> 5, c8 = idx & 31, hh = c8 >> 3;
        const float l0 = LSE[((size_t)0 * MC + row) * 4 + hh], l1 = LSE[((size_t)1 * MC + row) * 4 + hh], l2 = LSE[((size_t)2 * MC + row) * 4 + hh];
        const float mx = fmaxf(l0, fmaxf(l1, l2));
        float w0 = __builtin_amdgcn_exp2f(l0 - mx), w1 = __builtin_amdgcn_exp2f(l1 - mx), w2 = __builtin_amdgcn_exp2f(l2 - mx);
        const float inv = 1.0f / (w0 + w1 + w2); w0 *= inv; w1 *= inv; w2 *= inv;
        const v4u a = *(const v4u*)(OG + ((size_t)0 * MC + row) * 256 + c8 * 8), b = *(const v4u*)(OG + ((size_t)1 * MC + row) * 256 + c8 * 8), c = *(const v4u*)(OG + ((size_t)2 * MC + row) * 256 + c8 * 8);
        v4u o;
        o.x = cvtpk(w0 * blo(a.x) + w1 * blo(b.x) + w2 * blo(c.x), w0 * bhi(a.x) + w1 * bhi(b.x) + w2 * bhi(c.x));
        o.y = cvtpk(w0 * blo(a.y) + w1 * blo(b.y) + w2 * blo(c.y), w0 * bhi(a.y) + w1 * bhi(b.y) + w2 * bhi(c.y));
        o.z = cvtpk(w0 * blo(a.z) + w1 * blo(b.z) + w2 * blo(c.z), w0 * bhi(a.z) + w1 * bhi(b.z) + w2 * bhi(c.z));
        o.w = cvtpk(w0 * blo(a.w) + w1 * blo(b.w) + w2 * blo(c.w), w0 * bhi(a.w) + w1 * bhi(b.w) + w2 * bhi(c.w));
        *(v4u*)(ATT + (size_t)row * 256 + c8 * 8) = o;
    }
    for (int idx = gt; idx < (MC / 16) * 128; idx += NT) {
        const int cg8 = idx & 127, rb = idx >> 7, col = cg8 * 8, t0 = rb * 16;
        float k0[8], k1[8], k2[8];
#pragma unroll
        for (int j = 0; j < 8; ++j) { k0[j] = convw[col + j]; k1[j] = convw[D + col + j]; k2[j] = convw[2 * D + col + j]; }
        float up[8], uc[8], un[8];
        if ((t0 & (SEQ - 1)) == 0) {
#pragma unroll
            for (int j = 0; j < 8; ++j) up[j] = 0.f;
        } else loadu(Zc, t0 - 1, col, up);
        loadu(Zc, t0, col, uc);
        for (int i = 0; i < 16; ++i) {
            const int row = t0 + i;
            if (((row + 1) & (SEQ - 1)) == 0) {
#pragma unroll
                for (int j = 0; j < 8; ++j) un[j] = 0.f;
            } else loadu(Zc, row + 1, col, un);
            const v4u bb = *(const v4u*)(Zc + (size_t)row * INW + ZCB + col);
            float cv[8];
#pragma unroll
            for (int j = 0; j < 8; ++j) cv[j] = up[j] * k0[j] + uc[j] * k1[j] + un[j] * k2[j];
            v4u o;
            o.x = cvtpk(blo(bb.x) * cv[0], bhi(bb.x) * cv[1]); o.y = cvtpk(blo(bb.y) * cv[2], bhi(bb.y) * cv[3]);
            o.z = cvtpk(blo(bb.z) * cv[4], bhi(bb.z) * cv[5]); o.w = cvtpk(blo(bb.w) * cv[6], bhi(bb.w) * cv[7]);
            *(v4u*)(CBUF + (size_t)row * D + col) = o;
#pragma unroll
            for (int j = 0; j < 8; ++j) { up[j] = uc[j]; uc[j] = un[j]; }
        }
    }
}

__device__ __forceinline__ void resid_norm_phase(const float* xi_a, const float* xi_b, int rowbase, const bf16* Y, const float* PART, const float* g, float* xo, bf16* XBc, float* RSc,
                                                 int blk, int G, int wave, int lane) {
    for (int lr = blk * NWAVES + wave; lr < MC; lr += G * NWAVES) {
        const int row = rowbase + lr;
        const f32x4* pp = (const f32x4*)(PART + (size_t)lr * 16);
        const f32x4 p0 = pp[0], p1 = pp[1], p2 = pp[2], p3 = pp[3];
        const float ssy = ((p0[0] + p0[1]) + (p0[2] + p0[3])) + ((p1[0] + p1[1]) + (p1[2] + p1[3])) + ((p2[0] + p2[1]) + (p2[2] + p2[3])) + ((p3[0] + p3[1]) + (p3[2] + p3[3]));
        const float rsy = 1.0f / sqrtf(ssy * (1.0f / D) + NORM_EPS);
        const float* xr = row < NPROMPT_ROWS ? xi_a + (size_t)row * D : xi_b + (size_t)(row - NPROMPT_ROWS) * D;
        float ss = 0.f;
#pragma unroll
        for (int j = 0; j < 4; ++j) {
            const f32x4 xv = *((const f32x4*)xr + lane + 64 * j), gv = *((const f32x4*)g + lane + 64 * j);
            const v2u yv = *((const v2u*)(Y + (size_t)lr * D) + lane + 64 * j);
            f32x4 o;
            o[0] = xv[0] + blo(yv.x) * rsy * gv[0]; o[1] = xv[1] + bhi(yv.x) * rsy * gv[1]; o[2] = xv[2] + blo(yv.y) * rsy * gv[2]; o[3] = xv[3] + bhi(yv.y) * rsy * gv[3];
            ss += (o[0] * o[0] + o[1] * o[1]) + (o[2] * o[2] + o[3] * o[3]);
            *((f32x4*)(xo + (size_t)row * D) + lane + 64 * j) = o;
            v2u w; w.x = cvtpk(o[0], o[1]); w.y = cvtpk(o[2], o[3]); *((v2u*)(XBc + (size_t)lr * D) + lane + 64 * j) = w;
        }
        ss = wave_sum(ss);
        if (lane == 0) RSc[lr] = 1.0f / sqrtf(ss * (1.0f / D) + NORM_EPS);
    }
}

#define XB_TMO      128
#define XB_XCNT(j)  (256  + 64 * (j))
#define XB_XSUB(j)  (1280 + 64 * (j))
#define XB_XGEN(j)  (2304 + 64 * (j))
#define XB_TOP      3328
#define XB_TOPGEN   3392
#define XCD_BAR_WORDS 3456
#define XB_SPIN_CAP (1u << 18)

__device__ __forceinline__ unsigned xb_ld(unsigned* p)              { return __hip_atomic_load(p, __ATOMIC_RELAXED, __HIP_MEMORY_SCOPE_AGENT); }
__device__ __forceinline__ unsigned xb_add(unsigned* p, unsigned v) { return __hip_atomic_fetch_add(p, v, __ATOMIC_RELAXED, __HIP_MEMORY_SCOPE_AGENT); }
__device__ __forceinline__ unsigned xb_xcc_id() { return (unsigned)__builtin_amdgcn_s_getreg((3 << 11) | 20) & 0xFu; }
#define XB_SPIN(cond, bar) do { unsigned _sp = 0; while (cond) { __builtin_amdgcn_s_sleep(1); \
    if ((++_sp & 255u) == 0u) { if (xb_ld(&(bar)[XB_TMO])) break; if (_sp > XB_SPIN_CAP) { atomicAdd(&(bar)[XB_TMO], 1u); break; } } } } while (0)

struct XcdBarrier {
    unsigned* bar; unsigned x;
    volatile LAS unsigned* st;
};

__device__ __forceinline__ XcdBarrier xcd_barrier_post(unsigned* bar, volatile LAS unsigned* st) {
    XcdBarrier b; b.bar = bar; b.x = xb_xcc_id(); b.st = st;
    if (threadIdx.x == 0) (void)xb_add(&bar[XB_XCNT(b.x)], 1u);
    return b;
}
__device__ __forceinline__ void xcd_barrier_complete(unsigned* bar, unsigned x, unsigned& nloc, unsigned& nx) {
    const unsigned G = gridDim.x * gridDim.y * gridDim.z;
    unsigned sum, cnt, mine, sp = 0u;
    for (;;) {
        sum = 0u; cnt = 0u; mine = 0u;
#pragma unroll
        for (unsigned j = 0; j < 16; ++j) { const unsigned c = xb_ld(&bar[XB_XCNT(j)]); sum += c; cnt += (c > 0u) ? 1u : 0u; mine = (j == x) ? c : mine; }
        if (sum == G) break;
        __builtin_amdgcn_s_sleep(1);
        if ((++sp & 255u) == 0u) { if (xb_ld(&bar[XB_TMO])) break; if (sp > XB_SPIN_CAP) { atomicAdd(&bar[XB_TMO], 1u); break; } }
    }
    nloc = mine > 0u ? mine : 1u; nx = cnt > 0u ? cnt : 1u;
}

__device__ __forceinline__ void xcd_barrier(const XcdBarrier& b) {
    asm volatile("s_waitcnt vmcnt(0)" ::: "memory");
    __syncthreads();
    if (threadIdx.x == 0) {
        unsigned* bar = b.bar;
        __builtin_amdgcn_s_waitcnt(0);
        unsigned nloc = b.st[0], nx = b.st[1];
        if (nloc == 0u) { xcd_barrier_complete(bar, b.x, nloc, nx); b.st[0] = nloc; b.st[1] = nx; }
        const unsigned old = xb_add(&bar[XB_XSUB(b.x)], 1u);
        const unsigned gen = old / nloc;
        if (old + 1u == (gen + 1u) * nloc) {
            __builtin_amdgcn_fence(__ATOMIC_RELEASE, "agent");
            asm volatile("s_waitcnt vmcnt(0)" ::: "memory");
            const unsigned og = xb_add(&bar[XB_TOP], 1u);
            const unsigned tg = og / nx;
            if (og + 1u == (tg + 1u) * nx) xb_add(&bar[XB_TOPGEN], 1u);
            else XB_SPIN(xb_ld(&bar[XB_TOPGEN]) == tg, bar);
            __builtin_amdgcn_fence(__ATOMIC_ACQUIRE, "agent");
            xb_add(&bar[XB_XGEN(b.x)], 1u);
            asm volatile("s_waitcnt vmcnt(0)" ::: "memory");
        } else {
            XB_SPIN(xb_ld(&bar[XB_XGEN(b.x)]) == gen, bar);
            __builtin_amdgcn_fence(__ATOMIC_ACQUIRE, "agent");
            asm volatile("s_waitcnt vmcnt(0)" ::: "memory");
        }
    }
    __syncthreads();
}

__device__ __forceinline__ KArgs kargs() { auto p = __builtin_amdgcn_kernarg_segment_ptr(); asm volatile("" : "+s"(p)); return (KArgs)p; }
#ifndef PHM
#define PHM 0xFFFF
#endif
#ifndef REP_GEMM
#define REP_GEMM 1
#endif
#ifndef REP_ATT
#define REP_ATT 1
#endif
#ifndef REP_CC
#define REP_CC 1
#endif
#ifndef REP_SYNC
#define REP_SYNC 0
#endif
__global__ void __launch_bounds__(NWAVES * 64, 2) fwd_megakernel(Args a_unused) {
    extern __shared__ __attribute__((aligned(16))) unsigned char lds_raw[];
    cg::grid_group grid = cg::this_grid();
    LAS unsigned char* lds = (LAS unsigned char*)lds_raw;
#define XSYNC1() do { XcdBarrier b_; b_.bar = (unsigned*)(kargs()->ws + WS_BAR); b_.x = xb_xcc_id(); b_.st = (volatile LAS unsigned*)(lds + 131072); xcd_barrier(b_); } while (0)
#define GSYNC() do { XSYNC1(); for (int rs_ = 0; rs_ < REP_SYNC; ++rs_) XSYNC1(); } while (0)
    if (threadIdx.x == 0) { ((volatile LAS unsigned*)(lds + 131072))[0] = 0u; ((volatile LAS unsigned*)(lds + 131072))[1] = 0u; }
    __syncthreads();
    (void)xcd_barrier_post((unsigned*)(kargs()->ws + WS_BAR), (volatile LAS unsigned*)(lds + 131072));
#define WAVE_LANE int tid_ = threadIdx.x; asm volatile("" : "+v"(tid_)); const int lane = tid_ & 63, wave = __builtin_amdgcn_readfirstlane(tid_ >> 6)
#define BLK_G int blk = blockIdx.x, G = gridDim.x; asm volatile("" : "+s"(blk), "+s"(G))
#define WPTR(l, off) ((const bf16*)(ws + WS_W + (size_t)(l) * LW_SIZE + (off)))
    if constexpr ((PHM & 1) != 0) { WAVE_LANE; BLK_G; KArgs a = kargs(); p0_prologue(a, lds, blk, G, wave, lane); }
    grid.sync();

    for (int l = 0; l < DEPTH; ++l) {
        for (int ch = 0; ch < NCHUNK; ++ch) {
            for (int rep_ = 0; rep_ < REP_GEMM; ++rep_) if constexpr ((PHM & 2) != 0) {
                BLK_G; KArgs A = kargs(); unsigned char* ws = A->ws; const int rowbase = ch * MC;
                pg8::Gemm g{(const bf16*)(ws + WS_XB) + (size_t)rowbase * D, WPTR(l, LW_IN), MC, INW, D}; pg8::StaticOrder S; S.init(MC, INW, G, blk);
                pg8::EpiIn E{(bf16*)(ws + WS_Z), (const float*)(ws + WS_RS) + rowbase, (const float*)(ws + WS_ROPE), INW};
                pg8::gemm_phase<pg8::EpiIn, pg8::StaticOrder, true, true>(lds, g, S, E);
            }
            GSYNC();
            for (int rep_ = 0; rep_ < REP_ATT; ++rep_) if constexpr ((PHM & 4) != 0) { WAVE_LANE; BLK_G; KArgs A = kargs(); unsigned char* ws = A->ws;
                attn_phase(lds, (const bf16*)(ws + WS_Z), (bf16*)(ws + WS_OG), (float*)(ws + WS_LSE), blk, G, wave, lane); }
            GSYNC();
            for (int rep_ = 0; rep_ < REP_CC; ++rep_) if constexpr ((PHM & 8) != 0) { BLK_G; KArgs A = kargs(); unsigned char* ws = A->ws;
                combine_conv_phase((const bf16*)(ws + WS_Z), (const bf16*)(ws + WS_OG), (const float*)(ws + WS_LSE), (bf16*)(ws + WS_ATT), (bf16*)(ws + WS_RA), A->in[8] + (size_t)l * 3 * D, blk, G); }
            GSYNC();
            for (int rep_ = 0; rep_ < REP_GEMM; ++rep_) {
            if constexpr ((PHM & 16) != 0) {
                BLK_G; KArgs A = kargs(); unsigned char* ws = A->ws;
                pg8::Gemm g{(const bf16*)(ws + WS_ATT), WPTR(l, LW_A), MC, D, 256}; pg8::StaticOrder S; S.init(MC, D, G, blk);
                pg8::EpiGate<false> E{(const bf16*)(ws + WS_Z) + ZGA, INW, (bf16*)(ws + WS_RB), D};
                pg8::gemm_phase<pg8::EpiGate<false>, pg8::StaticOrder, true, true>(lds, g, S, E);
            }
            if constexpr ((PHM & 32) != 0) {
                BLK_G; KArgs A = kargs(); unsigned char* ws = A->ws;
                pg8::Gemm g{(const bf16*)(ws + WS_RA), WPTR(l, LW_C), MC, D, D}; pg8::StaticOrder S; S.init(MC, D, G, blk);
                pg8::EpiGate<true> E{(const bf16*)(ws + WS_Z) + ZGC, INW, (bf16*)(ws + WS_RB), D};
                pg8::gemm_phase<pg8::EpiGate<true>, pg8::StaticOrder, true, true>(lds, g, S, E);
            }
            }
            GSYNC();
            for (int rep_ = 0; rep_ < REP_GEMM; ++rep_) if constexpr ((PHM & 64) != 0) {
                BLK_G; KArgs A = kargs(); unsigned char* ws = A->ws;
                pg8::Gemm g{(const bf16*)(ws + WS_RB), WPTR(l, LW_O), MC, D, D}; pg8::StaticOrder S; S.init(MC, D, G, blk);
                pg8::EpiSq E{(bf16*)(ws + WS_RA), D, (float*)(ws + WS_PART)};
                pg8::gemm_phase<pg8::EpiSq, pg8::StaticOrder, true, true>(lds, g, S, E);
            }
            GSYNC();
            if constexpr ((PHM & 128) != 0) { WAVE_LANE; BLK_G; KArgs A = kargs(); unsigned char* ws = A->ws; const int rowbase = ch * MC; float* out = A->out;
                const float* xa = l == 0 ? A->in[0] : out; const float* xb = l == 0 ? A->in[1] : out + (size_t)NPROMPT_ROWS * D;
                resid_norm_phase(xa, xb, rowbase, (const bf16*)(ws + WS_RA), (const float*)(ws + WS_PART), A->in[3] + l * D, out, (bf16*)(ws + WS_XB) + (size_t)rowbase * D, (float*)(ws + WS_RS) + rowbase,
                                 blk, G, wave, lane); }
            GSYNC();
            for (int rep_ = 0; rep_ < REP_GEMM; ++rep_) if constexpr ((PHM & 256) != 0) {
                BLK_G; KArgs A = kargs(); unsigned char* ws = A->ws; const int rowbase = ch * MC;
                pg8::Gemm g{(const bf16*)(ws + WS_XB) + (size_t)rowbase * D, WPTR(l, LW_UP), MC, FF, D}; pg8::StaticOrder S; S.init(MC, FF, G, blk);
                pg8::EpiUp E{(bf16*)(ws + WS_Z), FF, (const float*)(ws + WS_RS) + rowbase};
                pg8::gemm_phase<pg8::EpiUp, pg8::StaticOrder, true, true>(lds, g, S, E);
            }
            GSYNC();
            for (int rep_ = 0; rep_ < REP_GEMM; ++rep_) if constexpr ((PHM & 512) != 0) {
                BLK_G; KArgs A = kargs(); unsigned char* ws = A->ws;
                pg8::Gemm g{(const bf16*)(ws + WS_Z), WPTR(l, LW_DN), MC, D, FF}; pg8::StaticOrder S; S.init(MC, D, G, blk);
                pg8::EpiSq E{(bf16*)(ws + WS_RA), D, (float*)(ws + WS_PART)};
                pg8::gemm_phase<pg8::EpiSq, pg8::StaticOrder, true, true>(lds, g, S, E);
            }
            GSYNC();
            if constexpr ((PHM & 1024) != 0) { WAVE_LANE; BLK_G; KArgs A = kargs(); unsigned char* ws = A->ws; const int rowbase = ch * MC; float* out = A->out;
                resid_norm_phase(out, out + (size_t)NPROMPT_ROWS * D, rowbase, (const bf16*)(ws + WS_RA), (const float*)(ws + WS_PART), A->in[5] + l * D, out, (bf16*)(ws + WS_XB) + (size_t)rowbase * D, (float*)(ws + WS_RS) + rowbase,
                                 blk, G, wave, lane); }
        }
    }
}

extern "C" void kernel_launch(void* const* d_in, const int* in_sizes, int n_in, void* d_out, int out_size, void* d_ws, size_t ws_size, hipStream_t stream) {
    static int grid = 0;
    if (grid == 0) {
        if (n_in != 13 || out_size != M * D || ws_size < WS_END) { fprintf(stderr, "kernel_launch: unexpected shapes / workspace (%d inputs, out %d, ws %zu < %zu)\n", n_in, out_size, ws_size, (size_t)WS_END); grid = -1; return; }
        int dev = 0, cus = 0, per_cu = 0;
        (void)hipGetDevice(&dev); (void)hipDeviceGetAttribute(&cus, hipDeviceAttributeMultiprocessorCount, dev);
        (void)hipFuncSetAttribute((const void*)fwd_megakernel, hipFuncAttributeMaxDynamicSharedMemorySize, LDS_BYTES);
        if (hipOccupancyMaxActiveBlocksPerMultiprocessor(&per_cu, (const void*)fwd_megakernel, NWAVES * 64, LDS_BYTES) != hipSuccess || per_cu < 1) per_cu = 1;
        (void)hipGetLastError();
        grid = cus * per_cu;
        if (grid <= 0) grid = 256;
    }
    if (grid < 0) return;
    Args a{};
    for (int i = 0; i < 13; ++i) a.in[i] = (const float*)d_in[i];
    a.out = (float*)d_out; a.ws = (unsigned char*)d_ws;
    (void)hipMemsetAsync((unsigned char*)d_ws + WS_BAR, 0, 16384, stream);
    void* args[] = {&a};
    hipError_t e = hipLaunchCooperativeKernel((const void*)fwd_megakernel, dim3(grid), dim3(NWAVES * 64), args, LDS_BYTES, stream);
    if (e != hipSuccess) fprintf(stderr, "cooperative launch failed: %s (grid %d)\n", hipGetErrorString(e), grid);
}
```

```cpp
#include <hip/hip_runtime.h>
#include <hip/hip_cooperative_groups.h>
#include <cstdio>
#include <cstdint>
namespace cg = cooperative_groups;
namespace pg8 {
#define PG8_LAS __attribute__((address_space(3)))
typedef unsigned short bf16_t;
typedef short bf16x8 __attribute__((ext_vector_type(8)));
typedef float f32x4 __attribute__((ext_vector_type(4)));
typedef unsigned u32x4 __attribute__((ext_vector_type(4)));
constexpr int BM = 256, BK = 64, HALF = 128, HTB = HALF * BK * 2  , STAGE_BYTES = 8 * HTB, NXCD = 8, WGM = 8;

__host__ __device__ __forceinline__ int lds_byte(int r, int c) { const int st = (r >> 4) * 2 + (c >> 5), rr = r & 15, cc = c & 31, ob = rr * 64 + cc * 2; return st * 1024 + (ob ^ (((ob >> 9) & 1) << 5)); }
__host__ __device__ __forceinline__ void stage_rc(int b, int& R, int& C) { const int st = b / 1024, sb = b % 1024, swz = sb ^ (((sb >> 9) & 1) << 5); R = (st >> 1) * 16 + swz / 64; C = (st & 1) * 32 + (swz % 64) / 2; }
__host__ __device__ __forceinline__ int perm32(int rho) { const int n = rho >> 4, i = rho & 15; return 8 * (i >> 2) + 4 * n + (i & 3); }

struct Unit { int pm, pn; };
struct Gemm { const bf16_t* A; const bf16_t* Bt; int M, N, K; };

struct StaticOrder {
    int nM, nN, nwg, G, c;
    __host__ __device__ void init(int M, int N, int G_, int c_) { nM = M / BM; nN = N / BM; nwg = nM * nN; G = G_; c = c_; }
    __host__ __device__ bool next(int i, Unit& u) const {
        const long L = (long)i * G + c; if (L >= nwg) return false;
        int wgid = (int)L; { const int q = nwg / NXCD, r = nwg % NXCD, xcd = wgid % NXCD, off = wgid / NXCD; wgid = (xcd < r ? xcd * (q + 1) : r * (q + 1) + (xcd - r) * q) + off; }
        const int nig = WGM * nN, gid = wgid / nig, fm = gid * WGM, gsz = (nM - fm) < WGM ? (nM - fm) : WGM;
        u.pm = fm + ((wgid % nig) % gsz); u.pn = (wgid % nig) / gsz; return true;
    }
    __device__ __forceinline__ void a_ready(const Unit&) const {}
    __device__ __forceinline__ void done(const Unit&) const {}
};

__device__ __forceinline__ unsigned cvt_pk_bf16(float lo, float hi) { unsigned r; asm volatile("v_cvt_pk_bf16_f32 %0, %1, %2" : "=v"(r) : "v"(lo), "v"(hi)); return r; }
__device__ __forceinline__ float bf_lo(unsigned w) { return __uint_as_float(w << 16); }
__device__ __forceinline__ float bf_hi(unsigned w) { return __uint_as_float(w & 0xffff0000u); }
__device__ __forceinline__ float sigm(float x) { return __builtin_amdgcn_rcpf(1.0f + __builtin_amdgcn_exp2f(-1.4426950408889634f * x)); }
constexpr float QSCALE = 0.125f * 1.4426950408889634f;

struct EpiIn {
    static constexpr bool PERM = true, AFTER_DRAIN = false;
    bf16_t* Z; const float* rs; const float* rope; int ldc;
    __device__ __forceinline__ void operator()(const f32x4 (&acc)[2][2][4][2], const Unit& u, int wr, int wc, int fr, int fq) const {
        const int row0 = u.pm * BM + wr * 64 + fr, col0 = u.pn * BM + wc * 32 + 8 * fq;
        const int G = 4 * (wc & 1) + fq;
        if (u.pn < 6) {
            const float qs = u.pn < 3 ? QSCALE : 1.0f;
#pragma unroll
            for (int ai = 0; ai < 2; ++ai)
#pragma unroll
                for (int m = 0; m < 4; ++m) {
                    const int row = row0 + ai * HALF + m * 16; const float s = rs[row] * qs;
                    const f32x4* rp = (const f32x4*)(rope + ((size_t)(row & 4095) * 32 + 4 * G) * 2);
                    const f32x4 r0 = rp[0], r1 = rp[1];
                    const f32x4 cs = (f32x4){r0[0], r0[2], r1[0], r1[2]}, sn = (f32x4){r0[1], r0[3], r1[1], r1[3]};
                    bf16_t* rowp = Z + (size_t)row * ldc + col0;
#pragma unroll
                    for (int bj = 0; bj < 2; ++bj) {
                        const f32x4 lo = acc[ai][bj][m][0] * s, hi = acc[ai][bj][m][1] * s;
                        const f32x4 ol = lo * cs - hi * sn, oh = hi * cs + lo * sn;
                        u32x4 w; w.x = cvt_pk_bf16(ol[0], ol[1]); w.y = cvt_pk_bf16(ol[2], ol[3]); w.z = cvt_pk_bf16(oh[0], oh[1]); w.w = cvt_pk_bf16(oh[2], oh[3]);
                        *(u32x4*)(rowp + bj * HALF) = w; }
                }
        } else {
#pragma unroll
            for (int ai = 0; ai < 2; ++ai)
#pragma unroll
                for (int m = 0; m < 4; ++m) {
                    const int row = row0 + ai * HALF + m * 16; const float s = rs[row];
                    bf16_t* rowp = Z + (size_t)row * ldc + col0;
#pragma unroll
                    for (int bj = 0; bj < 2; ++bj) {
                        const f32x4 v0 = acc[ai][bj][m][0] * s, v1 = acc[ai][bj][m][1] * s;
                        u32x4 w; w.x = cvt_pk_bf16(v0[0], v0[1]); w.y = cvt_pk_bf16(v0[2], v0[3]); w.z = cvt_pk_bf16(v1[0], v1[1]); w.w = cvt_pk_bf16(v1[2], v1[3]);
                        *(u32x4*)(rowp + bj * HALF) = w; }
                }
        }
    }
};
template <bool ADD> struct EpiGate {
    static constexpr bool PERM = true, AFTER_DRAIN = false;
    const bf16_t* gate; int ldg; bf16_t* O; int ldc;
    __device__ __forceinline__ void operator()(const f32x4 (&acc)[2][2][4][2], const Unit& u, int wr, int wc, int fr, int fq) const {
        const int row0 = u.pm * BM + wr * 64 + fr, col0 = u.pn * BM + wc * 32 + 8 * fq;
#pragma unroll
        for (int ai = 0; ai < 2; ++ai)
#pragma unroll
            for (int m = 0; m < 4; ++m) {
                const int row = row0 + ai * HALF + m * 16;
#pragma unroll
                for (int bj = 0; bj < 2; ++bj) {
                    const u32x4 g = *(const u32x4*)(gate + (size_t)row * ldg + col0 + bj * HALF);
                    bf16_t* op = O + (size_t)row * ldc + col0 + bj * HALF;
                    f32x4 v0 = acc[ai][bj][m][0], v1 = acc[ai][bj][m][1];
                    v0[0] *= sigm(bf_lo(g.x)); v0[1] *= sigm(bf_hi(g.x)); v0[2] *= sigm(bf_lo(g.y)); v0[3] *= sigm(bf_hi(g.y));
                    v1[0] *= sigm(bf_lo(g.z)); v1[1] *= sigm(bf_hi(g.z)); v1[2] *= sigm(bf_lo(g.w)); v1[3] *= sigm(bf_hi(g.w));
                    if (ADD) { const u32x4 t = *(const u32x4*)op;
                        v0[0] += bf_lo(t.x); v0[1] += bf_hi(t.x); v0[2] += bf_lo(t.y); v0[3] += bf_hi(t.y);
                        v1[0] += bf_lo(t.z); v1[1] += bf_hi(t.z); v1[2] += bf_lo(t.w); v1[3] += bf_hi(t.w); }
                    u32x4 w; w.x = cvt_pk_bf16(v0[0], v0[1]); w.y = cvt_pk_bf16(v0[2], v0[3]); w.z = cvt_pk_bf16(v1[0], v1[1]); w.w = cvt_pk_bf16(v1[2], v1[3]);
                    *(u32x4*)op = w; }
                asm volatile("" ::: "memory");
            }
    }
};
struct EpiSq {
    static constexpr bool PERM = true, AFTER_DRAIN = false;
    bf16_t* O; int ldc; float* part;
    __device__ __forceinline__ void operator()(const f32x4 (&acc)[2][2][4][2], const Unit& u, int wr, int wc, int fr, int fq) const {
        const int row0 = u.pm * BM + wr * 64 + fr, col0 = u.pn * BM + wc * 32 + 8 * fq;
#pragma unroll
        for (int ai = 0; ai < 2; ++ai)
#pragma unroll
            for (int m = 0; m < 4; ++m) {
                const int row = row0 + ai * HALF + m * 16; float s = 0.f;
#pragma unroll
                for (int bj = 0; bj < 2; ++bj) {
                    const f32x4 v0 = acc[ai][bj][m][0], v1 = acc[ai][bj][m][1];
                    s += (v0[0] * v0[0] + v0[1] * v0[1]) + (v0[2] * v0[2] + v0[3] * v0[3]) + (v1[0] * v1[0] + v1[1] * v1[1]) + (v1[2] * v1[2] + v1[3] * v1[3]);
                    u32x4 w; w.x = cvt_pk_bf16(v0[0], v0[1]); w.y = cvt_pk_bf16(v0[2], v0[3]); w.z = cvt_pk_bf16(v1[0], v1[1]); w.w = cvt_pk_bf16(v1[2], v1[3]);
                    *(u32x4*)(O + (size_t)row * ldc + col0 + bj * HALF) = w; }
                s += __shfl_xor(s, 16); s += __shfl_xor(s, 32);
                if (fq == 0) part[(size_t)row * 16 + u.pn * 4 + wc] = s;
            }
    }
};
struct EpiUp {
    static constexpr bool PERM = true, AFTER_DRAIN = false;
    bf16_t* O; int ldc; const float* rs;
    __device__ __forceinline__ void operator()(const f32x4 (&acc)[2][2][4][2], const Unit& u, int wr, int wc, int fr, int fq) const {
        const int row0 = u.pm * BM + wr * 64 + fr, col0 = u.pn * BM + wc * 32 + 8 * fq;
#pragma unroll
        for (int ai = 0; ai < 2; ++ai)
#pragma unroll
            for (int m = 0; m < 4; ++m) {
                const int row = row0 + ai * HALF + m * 16; const float s = rs[row];
#pragma unroll
                for (int bj = 0; bj < 2; ++bj) {
                    f32x4 v0 = acc[ai][bj][m][0] * s, v1 = acc[ai][bj][m][1] * s;
#pragma unroll
                    for (int j = 0; j < 4; ++j) { const float a = fmaxf(v0[j], 0.f), b = fmaxf(v1[j], 0.f); v0[j] = a * a; v1[j] = b * b; }
                    u32x4 w; w.x = cvt_pk_bf16(v0[0], v0[1]); w.y = cvt_pk_bf16(v0[2], v0[3]); w.z = cvt_pk_bf16(v1[0], v1[1]); w.w = cvt_pk_bf16(v1[2], v1[3]);
                    *(u32x4*)(O + (size_t)row * ldc + col0 + bj * HALF) = w; }
            }
    }
};

template <class Epi, class Sched, bool ALIGN_EPI = false, bool SP2 = false>
__device__ __forceinline__ void gemm_phase(PG8_LAS unsigned char* lds, const Gemm g, const Sched& S, const Epi& E) {
    int tid_ = threadIdx.x; asm volatile("" : "+v"(tid_));
    const int tid = tid_, wid = __builtin_amdgcn_readfirstlane(tid >> 6), lane = tid & 63, wr = wid >> 2, wc = wid & 3, fr = lane & 15, fq = lane >> 4;
    const int K = g.K, nt = K / BK;
    unsigned voffA[2], voffB[2];
#pragma unroll
    for (int i = 0; i < 2; ++i) { int R, C; stage_rc(tid * 16 + i * 8192, R, C); const int Rb = Epi::PERM ? ((R & ~31) + perm32(R & 31)) : R;
        voffA[i] = (unsigned)(R * K + C) * 2u; voffB[i] = (unsigned)(Rb * K + C) * 2u; }
    const size_t kstep = (size_t)(BK * 2);
    const size_t hstep = (size_t)HALF * K * 2;
    const size_t tstep = 2 * hstep;
    const unsigned ldsw = (unsigned)wid * 1024u;
    const int aoff = lds_byte(wr * 64 + fr, fq * 8), boff = lds_byte(wc * 32 + fr, fq * 8);
#define PG8_SA(b, h) (((b) * 2 + (h)) * HTB)
#define PG8_SB(b, h) ((4 + (b) * 2 + (h)) * HTB)
#define PG8_STAGE(bufoff, gbase, voff) do { _Pragma("unroll") for (int _i = 0; _i < 2; ++_i) \
        __builtin_amdgcn_global_load_lds((const unsigned*)((const char*)(gbase) + (voff)[_i]), (PG8_LAS unsigned*)(lds + (bufoff) + ldsw + _i * 8192), 16, 0, 0); } while (0)
#define PG8_LDA(dst, b, h) do { _Pragma("unroll") for (int m = 0; m < 4; ++m) _Pragma("unroll") for (int k = 0; k < 2; ++k) dst[m][k] = *(const PG8_LAS bf16x8*)(lds + PG8_SA(b, h) + aoff + m * 2048 + k * 1024); } while (0)
#define PG8_LDB(dst, b, h) do { _Pragma("unroll") for (int n = 0; n < 2; ++n) _Pragma("unroll") for (int k = 0; k < 2; ++k) dst[n][k] = *(const PG8_LAS bf16x8*)(lds + PG8_SB(b, h) + boff + n * 2048 + k * 1024); } while (0)
#define PG8_MMA(ai, bj, At, Bt) do { __builtin_amdgcn_s_setprio(1); _Pragma("unroll") for (int m = 0; m < 4; ++m) _Pragma("unroll") for (int n = 0; n < 2; ++n) _Pragma("unroll") for (int k = 0; k < 2; ++k) \
        acc[ai][bj][m][n] = __builtin_amdgcn_mfma_f32_16x16x32_bf16(Bt[n][k], At[m][k], acc[ai][bj][m][n], 0, 0, 0); __builtin_amdgcn_s_setprio(0); } while (0)
#define PG8_WAIT_V(n) asm volatile("s_waitcnt vmcnt(" #n ")" ::: "memory")
#define PG8_WAIT_L(n) asm volatile("s_waitcnt lgkmcnt(" #n ")" ::: "memory")
#define PG8_BAR __builtin_amdgcn_s_barrier()
#define PG8_SCHED __builtin_amdgcn_sched_barrier(0)
    Unit cur, nxt; int ui = 0;
    if (!S.next(0, cur)) return;
    f32x4 acc[2][2][4][2];
#pragma unroll
    for (int a = 0; a < 2; ++a)
#pragma unroll
        for (int b = 0; b < 2; ++b)
#pragma unroll
            for (int m = 0; m < 4; ++m)
#pragma unroll
                for (int n = 0; n < 2; ++n) acc[a][b][m][n] = (f32x4){0.f, 0.f, 0.f, 0.f};
    bf16x8 At[4][2], B0[2][2], B1[2][2];
    const char* cA = (const char*)g.A + (size_t)cur.pm * tstep; const char* cB = (const char*)g.Bt + (size_t)cur.pn * tstep;
    S.a_ready(cur);
    if constexpr (SP2) {
        PG8_STAGE(PG8_SB(0, 0), cB, voffB); PG8_STAGE(PG8_SB(0, 1), cB + hstep, voffB); PG8_STAGE(PG8_SA(0, 0), cA, voffA); PG8_STAGE(PG8_SA(0, 1), cA + hstep, voffA);
        if (wr == 1) PG8_BAR;
        PG8_WAIT_V(2); PG8_BAR;
        PG8_STAGE(PG8_SB(1, 0), cB + kstep, voffB); PG8_STAGE(PG8_SA(1, 0), cA + kstep, voffA); PG8_STAGE(PG8_SB(1, 1), cB + hstep + kstep, voffB);
        PG8_WAIT_V(6); PG8_BAR;
    } else {
        PG8_STAGE(PG8_SB(0, 0), cB, voffB); PG8_STAGE(PG8_SA(0, 0), cA, voffA); PG8_STAGE(PG8_SB(0, 1), cB + hstep, voffB); PG8_STAGE(PG8_SA(0, 1), cA + hstep, voffA);
        if (wr == 1) PG8_BAR;
        PG8_WAIT_V(4); PG8_BAR;
        PG8_STAGE(PG8_SB(1, 0), cB + kstep, voffB); PG8_STAGE(PG8_SA(1, 0), cA + kstep, voffA); PG8_STAGE(PG8_SB(1, 1), cB + hstep + kstep, voffB);
        PG8_WAIT_V(6); PG8_BAR;
    }
    for (;;) {
        const bool has_next = S.next(ui + 1, nxt);
        const char* nA = has_next ? (const char*)g.A + (size_t)nxt.pm * tstep : cA; const char* nB = has_next ? (const char*)g.Bt + (size_t)nxt.pn * tstep : cB;
#pragma clang loop unroll(disable)
        for (int t = 0; t < nt; t += 2) {
            const bool last = (t == nt - 2);
            const char* a1 = cA + (size_t)(t + 1) * kstep;
            const char* a2 = last ? nA : cA + (size_t)(t + 2) * kstep; const char* b2 = last ? nB : cB + (size_t)(t + 2) * kstep;
            const char* a3 = a2 + kstep; const char* b3 = b2 + kstep;
            if (last && has_next) S.a_ready(nxt);
            if constexpr (SP2) {
            PG8_LDB(B0, 0, 0); PG8_LDB(B1, 0, 1); PG8_SCHED; PG8_LDA(At, 0, 0); PG8_STAGE(PG8_SA(1, 1), a1 + hstep, voffA);
            PG8_WAIT_V(8); PG8_WAIT_L(0); PG8_BAR; PG8_MMA(0, 0, At, B0); PG8_MMA(0, 1, At, B1); PG8_BAR; PG8_SCHED;
            PG8_LDA(At, 0, 1); PG8_STAGE(PG8_SB(0, 0), b2, voffB); PG8_STAGE(PG8_SB(0, 1), b2 + hstep, voffB); PG8_STAGE(PG8_SA(0, 0), a2, voffA);
            PG8_WAIT_V(8); PG8_WAIT_L(0); PG8_BAR; PG8_MMA(1, 0, At, B0); PG8_MMA(1, 1, At, B1); PG8_BAR; PG8_SCHED;
            PG8_LDB(B0, 1, 0); PG8_LDB(B1, 1, 1); PG8_SCHED; PG8_LDA(At, 1, 0); PG8_STAGE(PG8_SA(0, 1), a2 + hstep, voffA);
            PG8_WAIT_V(8); PG8_WAIT_L(0); PG8_BAR; PG8_MMA(0, 0, At, B0); PG8_MMA(0, 1, At, B1); PG8_BAR; PG8_SCHED;
            PG8_LDA(At, 1, 1); PG8_STAGE(PG8_SB(1, 0), b3, voffB); PG8_STAGE(PG8_SB(1, 1), b3 + hstep, voffB); PG8_STAGE(PG8_SA(1, 0), a3, voffA);
            PG8_WAIT_V(8); PG8_WAIT_L(0); PG8_BAR; PG8_MMA(1, 0, At, B0); PG8_MMA(1, 1, At, B1); PG8_BAR; PG8_SCHED;
            } else {
            PG8_LDB(B0, 0, 0); PG8_SCHED; PG8_LDA(At, 0, 0); PG8_STAGE(PG8_SA(1, 1), a1 + hstep, voffA);
            PG8_WAIT_L(8); PG8_BAR; PG8_WAIT_L(0); PG8_MMA(0, 0, At, B0); PG8_BAR; PG8_SCHED;
            PG8_LDB(B1, 0, 1); PG8_STAGE(PG8_SB(0, 0), b2, voffB);
            PG8_BAR; PG8_WAIT_L(0); PG8_MMA(0, 1, At, B1); PG8_BAR;
            PG8_LDA(At, 0, 1); PG8_STAGE(PG8_SA(0, 0), a2, voffA);
            PG8_BAR; PG8_WAIT_L(0); PG8_MMA(1, 0, At, B0); PG8_BAR; PG8_SCHED;
            PG8_STAGE(PG8_SB(0, 1), b2 + hstep, voffB);
            PG8_WAIT_V(6); PG8_BAR; PG8_MMA(1, 1, At, B1); PG8_BAR;
            PG8_LDB(B0, 1, 0); PG8_SCHED; PG8_LDA(At, 1, 0); PG8_STAGE(PG8_SA(0, 1), a2 + hstep, voffA);
            PG8_WAIT_L(8); PG8_BAR; PG8_WAIT_L(0); PG8_MMA(0, 0, At, B0); PG8_BAR; PG8_SCHED;
            PG8_LDB(B1, 1, 1); PG8_STAGE(PG8_SB(1, 0), b3, voffB);
            PG8_BAR; PG8_WAIT_L(0); PG8_MMA(0, 1, At, B1); PG8_BAR;
            PG8_LDA(At, 1, 1); PG8_STAGE(PG8_SA(1, 0), a3, voffA);
            PG8_BAR; PG8_WAIT_L(0); PG8_MMA(1, 0, At, B0); PG8_BAR; PG8_SCHED;
            PG8_STAGE(PG8_SB(1, 1), b3 + hstep, voffB);
            PG8_WAIT_V(6); PG8_BAR; PG8_MMA(1, 1, At, B1); PG8_BAR;
            }
        }
        if constexpr (ALIGN_EPI) { if (wr == 0) PG8_BAR; }
        if constexpr (!Epi::AFTER_DRAIN) { E(acc, cur, wr, wc, fr, fq); S.done(cur); }
        if (!has_next) break;
#pragma unroll
        for (int a = 0; a < 2; ++a)
#pragma unroll
            for (int b = 0; b < 2; ++b)
#pragma unroll
                for (int m = 0; m < 4; ++m)
#pragma unroll
                    for (int n = 0; n < 2; ++n) acc[a][b][m][n] = (f32x4){0.f, 0.f, 0.f, 0.f};
        cur = nxt; cA = nA; cB = nB; ++ui;
        if constexpr (ALIGN_EPI) { if (wr == 1) PG8_BAR; }
    }
    PG8_WAIT_V(0);
    if constexpr (!ALIGN_EPI) { if (wr == 0) PG8_BAR; }
    PG8_BAR;
    if constexpr (Epi::AFTER_DRAIN) { E.fused(acc, cur, wr, wc, fr, fq, lds, wid, lane); S.done(cur); }
#undef PG8_SA
#undef PG8_SB
#undef PG8_STAGE
#undef PG8_LDA
#undef PG8_LDB
#undef PG8_MMA
#undef PG8_WAIT_V
#undef PG8_WAIT_L
#undef PG8_BAR
#undef PG8_SCHED
}
}

#define LAS __attribute__((address_space(3)))
typedef unsigned short bf16;
typedef unsigned v4u __attribute__((ext_vector_type(4)));
typedef unsigned v2u __attribute__((ext_vector_type(2)));
typedef float f32x4 __attribute__((ext_vector_type(4)));
typedef float f32x16 __attribute__((ext_vector_type(16)));
typedef short bf16x8 __attribute__((ext_vector_type(8)));
typedef short s16x4 __attribute__((ext_vector_type(4)));

constexpr int D = 1024, SEQ = 4096, NBATCH = 12, M = NBATCH * SEQ, INW = 7424, FF = 4096, DEPTH = 2, NPROMPT_ROWS = 8 * SEQ;
constexpr int CB = 4, MC = CB * SEQ, NCHUNK = NBATCH / CB;
constexpr int NWAVES = 8;
constexpr int LDS_BYTES = 147456;
constexpr float NORM_EPS = 1e-6f;
constexpr int ZQ = 0, ZK = 768, ZV = 1536, ZCB = 2304, ZCC = 3328, ZCH = 4352, ZGA = 5376, ZGC = 6400;

constexpr size_t WS_ROPE = 0;
constexpr size_t WS_RS = WS_ROPE + (size_t)SEQ * 32 * 8;
constexpr size_t WS_PART = WS_RS + (size_t)M * 4;
constexpr size_t WS_LSE = WS_PART + (size_t)MC * 16 * 4;
constexpr size_t WS_W = WS_LSE + (size_t)3 * MC * 4 * 4;
constexpr size_t LW_IN = 0, LW_A = LW_IN + (size_t)INW * D * 2, LW_C = LW_A + (size_t)D * 256 * 2, LW_O = LW_C + (size_t)D * D * 2,
                 LW_UP = LW_O + (size_t)D * D * 2, LW_DN = LW_UP + (size_t)FF * D * 2, LW_SIZE = LW_DN + (size_t)D * FF * 2;
constexpr size_t WS_XB = WS_W + DEPTH * LW_SIZE;
constexpr size_t WS_Z = WS_XB + (size_t)M * D * 2;
constexpr size_t WS_OG = WS_Z + (size_t)MC * INW * 2;
constexpr size_t WS_ATT = WS_OG + (size_t)3 * MC * 256 * 2;
constexpr size_t WS_RA = WS_ATT + (size_t)MC * 256 * 2;
constexpr size_t WS_RB = WS_RA + (size_t)MC * D * 2;
constexpr size_t WS_BAR = WS_RB + (size_t)MC * D * 2;
constexpr size_t WS_END = WS_BAR + 16384;
static_assert((size_t)MC * FF * 2 <= (size_t)MC * INW * 2, "H overlays Z");

__device__ __forceinline__ unsigned cvtpk(float lo, float hi) { unsigned r; asm volatile("v_cvt_pk_bf16_f32 %0, %1, %2" : "=v"(r) : "v"(lo), "v"(hi)); return r; }
__device__ __forceinline__ float blo(unsigned w) { return __uint_as_float(w << 16); }
__device__ __forceinline__ float bhi(unsigned w) { return __uint_as_float(w & 0xffff0000u); }
__device__ __forceinline__ float wave_sum(float v) {
#pragma unroll
    for (int o = 1; o < 64; o <<= 1) v += __shfl_xor(v, o);
    return v;
}
#define LDS_WAIT() asm volatile("s_waitcnt lgkmcnt(0)" ::: "memory")

struct Args { const float* in[13]; float* out; unsigned char* ws; };

__device__ __forceinline__ void p0_item(const float* W, int K, int N, bf16* WT, const float* gk, bool permqk, LAS float* scr, int item, int lane) {
    const int nblk = N / 32, kb = item / nblk, nb = item % nblk, k0 = 64 * kb, n0 = 32 * nb;
#pragma unroll 8
    for (int i = 0; i < 32; ++i) { const int kk = 2 * i + (lane >> 5); float w = W[(size_t)(k0 + kk) * N + n0 + (lane & 31)]; if (gk) w *= gk[k0 + kk]; scr[kk * 33 + (lane & 31)] = w; }
    LDS_WAIT(); asm volatile("" ::: "memory");
    const int c = lane & 7;
#pragma unroll
    for (int j = 0; j < 4; ++j) { const int n = (lane >> 3) + 8 * j; const LAS float* s = scr + (8 * c) * 33 + n;
        int nd = n0 + n;
        if (permqk && nd < 1536) { const int d = nd & 63; nd = (nd & ~63) + 8 * ((d & 31) >> 2) + 4 * (d >> 5) + (d & 3); }
        v4u o; o.x = cvtpk(s[0 * 33], s[1 * 33]); o.y = cvtpk(s[2 * 33], s[3 * 33]); o.z = cvtpk(s[4 * 33], s[5 * 33]); o.w = cvtpk(s[6 * 33], s[7 * 33]);
        *(v4u*)(WT + (size_t)nd * K + k0 + 8 * c) = o; }
    LDS_WAIT(); asm volatile("" ::: "memory");
}
__device__ __forceinline__ void sincos_d(double r, float& c, float& s) {
    const double r2 = r * r;
    double sp = 1.0 / 51090942171709440000.0;
    sp = sp * r2 - 1.0 / 121645100408832000.0; sp = sp * r2 + 1.0 / 355687428096000.0; sp = sp * r2 - 1.0 / 1307674368000.0; sp = sp * r2 + 1.0 / 6227020800.0;
    sp = sp * r2 - 1.0 / 39916800.0; sp = sp * r2 + 1.0 / 362880.0; sp = sp * r2 - 1.0 / 5040.0; sp = sp * r2 + 1.0 / 120.0; sp = sp * r2 - 1.0 / 6.0; sp = sp * r2 + 1.0;
    double cp = 1.0 / 1124000727777607680000.0;
    cp = cp * r2 - 1.0 / 2432902008176640000.0; cp = cp * r2 + 1.0 / 6402373705728000.0; cp = cp * r2 - 1.0 / 20922789888000.0; cp = cp * r2 + 1.0 / 87178291200.0;
    cp = cp * r2 - 1.0 / 479001600.0; cp = cp * r2 + 1.0 / 3628800.0; cp = cp * r2 - 1.0 / 40320.0; cp = cp * r2 + 1.0 / 720.0; cp = cp * r2 - 1.0 / 24.0; cp = cp * r2 + 0.5;
    s = (float)(sp * r); c = (float)(1.0 - cp * r2);
}
typedef const __attribute__((address_space(4))) Args* KArgs;
__device__ __forceinline__ void p0_prologue(KArgs ap, LAS unsigned char* lds, int blk, int G, int wave, int lane) {
    unsigned char* ws = ap->ws;
    LAS float* scr = (LAS float*)(lds + wave * 16384);
    const int gw = blk * NWAVES + wave, NGW = G * NWAVES;
    constexpr int I_IN = (D / 64) * (INW / 32), I_A = (256 / 64) * (D / 32), I_C = (D / 64) * (D / 32), I_O = I_C, I_UP = (D / 64) * (FF / 32), I_DN = (FF / 64) * (D / 32);
    constexpr int LAYER_ITEMS = I_IN + I_A + I_C + I_O + I_UP + I_DN;
    for (int it = gw; it < DEPTH * LAYER_ITEMS; it += NGW) {
        const int l = it / LAYER_ITEMS; int r = it % LAYER_ITEMS;
        unsigned char* wl = ws + WS_W + (size_t)l * LW_SIZE;
        if (r < I_IN) { p0_item(ap->in[6] + (size_t)l * D * INW, D, INW, (bf16*)(wl + LW_IN), ap->in[2] + l * D, true, scr, r, lane); continue; } r -= I_IN;
        if (r < I_A) { p0_item(ap->in[7] + (size_t)l * 256 * D, 256, D, (bf16*)(wl + LW_A), nullptr, false, scr, r, lane); continue; } r -= I_A;
        if (r < I_C) { p0_item(ap->in[9] + (size_t)l * D * D, D, D, (bf16*)(wl + LW_C), nullptr, false, scr, r, lane); continue; } r -= I_C;
        if (r < I_O) { p0_item(ap->in[10] + (size_t)l * D * D, D, D, (bf16*)(wl + LW_O), nullptr, false, scr, r, lane); continue; } r -= I_O;
        if (r < I_UP) { p0_item(ap->in[11] + (size_t)l * D * FF, D, FF, (bf16*)(wl + LW_UP), ap->in[4] + l * D, false, scr, r, lane); continue; } r -= I_UP;
        p0_item(ap->in[12] + (size_t)l * FF * D, FF, D, (bf16*)(wl + LW_DN), nullptr, false, scr, r, lane);
    }
    float* rope = (float*)(ws + WS_ROPE);
    for (int idx = blk * 512 + (int)threadIdx.x; idx < SEQ * 32; idx += G * 512) {
        const int pos = idx >> 5, i = idx & 31;
        const double inv = exp2(-(double)i * (13.287712379549449 / 32.0));
        const double ang = (double)pos * inv, k = rint(ang * 0.15915494309189535), r = ang - k * 6.283185307179586;
        float c, s; sincos_d(r, c, s); rope[2 * idx] = c; rope[2 * idx + 1] = s;
    }
    bf16* XB = (bf16*)(ws + WS_XB); float* RS = (float*)(ws + WS_RS);
    for (int row0 = gw; row0 < M; row0 += 4 * NGW) {
        f32x4 v[4][4];
#pragma unroll
        for (int u = 0; u < 4; ++u) { const int row = row0 + u * NGW; if (row < M) {
            const float* xr = row < NPROMPT_ROWS ? ap->in[0] + (size_t)row * D : ap->in[1] + (size_t)(row - NPROMPT_ROWS) * D;
#pragma unroll
            for (int j = 0; j < 4; ++j) v[u][j] = *((const f32x4*)xr + lane + 64 * j); } }
#pragma unroll
        for (int u = 0; u < 4; ++u) { const int row = row0 + u * NGW; if (row < M) {
            float ss = 0.f;
#pragma unroll
            for (int j = 0; j < 4; ++j) { const f32x4 t = v[u][j]; ss += (t[0] * t[0] + t[1] * t[1]) + (t[2] * t[2] + t[3] * t[3]);
                v2u o; o.x = cvtpk(t[0], t[1]); o.y = cvtpk(t[2], t[3]); *((v2u*)(XB + (size_t)row * D) + lane + 64 * j) = o; }
            ss = wave_sum(ss);
            if (lane == 0) RS[row] = 1.0f / sqrtf(ss * (1.0f / D) + NORM_EPS); } }
    }
}

__device__ __forceinline__ int crow(int r, int hi) { return (r & 3) + 8 * (r >> 2) + 4 * hi; }
__device__ __forceinline__ s16x4 vtr(const LAS unsigned char* p) { return __builtin_bit_cast(s16x4, __builtin_amdgcn_ds_read_tr16_b64_v4i16((LAS s16x4*)p)); }
__device__ __forceinline__ void attn_phase(LAS unsigned char* lds, const bf16* Zc, bf16* OG, float* LSE, int blk, int G, int wave, int lane) {
    constexpr int VST = 192;
    const int r32 = lane & 31, hi = lane >> 5;
    LAS unsigned char* vl = lds + wave * (32 * VST);
    const LAS unsigned char* vrd = vl + (4 * hi + ((lane & 15) >> 2)) * VST + ((lane >> 4) & 1) * 32 + (lane & 3) * 8;
    constexpr int NITEM = CB * 12 * 128;
    for (int item = blk * NWAVES + wave; item < NITEM; item += G * NWAVES) {
        const int sb = item & 127, gh = (item >> 7) % 12, bl = item / (128 * 12);
        const int g = gh >> 2, hh = gh & 3, sh = 2 * g, L = SEQ >> sh, nsb = 128 >> sh;
        const int c = sb / nsb, qb = sb % nsb, q0 = qb * 32;
        const size_t rowq = (size_t)bl * SEQ + ((size_t)(q0 + r32) << sh) + c;
        const bf16* qp = Zc + rowq * INW + ZQ + gh * 64 + 8 * hi;
        bf16x8 qf[4];
#pragma unroll
        for (int s = 0; s < 4; ++s) qf[s] = *(const bf16x8*)(qp + 16 * s);
        float m_run = -1e30f, l_run = 0.f; f32x16 o0, o1;
#pragma unroll
        for (int r = 0; r < 16; ++r) { o0[r] = 0.f; o1[r] = 0.f; }
        for (int t = 0; t < 5; ++t) {
            const int k0 = q0 - 64 + 32 * t; if (k0 < 0 || k0 >= L) continue;
            const size_t rowk = (size_t)bl * SEQ + ((size_t)(k0 + r32) << sh) + c;
            const bf16* kp = Zc + rowk * INW + ZK + gh * 64 + 8 * hi;
            bf16x8 kf[4];
#pragma unroll
            for (int s = 0; s < 4; ++s) kf[s] = *(const bf16x8*)(kp + 16 * s);
#pragma unroll
            for (int i = 0; i < 4; ++i) { const int id = lane + 64 * i, vr = id >> 3, ch = id & 7;
                const size_t rowv = (size_t)bl * SEQ + ((size_t)(k0 + vr) << sh) + c;
                const v4u v = *(const v4u*)(Zc + rowv * INW + ZV + gh * 64 + ch * 8);
                *(LAS v4u*)(vl + vr * VST + ch * 16) = v; }
            f32x16 p;
#pragma unroll
            for (int r = 0; r < 16; ++r) p[r] = 0.f;
#pragma unroll
            for (int s = 0; s < 4; ++s) p = __builtin_amdgcn_mfma_f32_32x32x16_bf16(kf[s], qf[s], p, 0, 0, 0);
            const int dq = q0 + r32 - k0;
            float mt = -1e30f;
#pragma unroll
            for (int r = 0; r < 16; ++r) { const int d = dq - crow(r, hi); const bool ok = (d <= 64) && (d >= -64); p[r] = ok ? p[r] : -1e30f; mt = fmaxf(mt, p[r]); }
            mt = fmaxf(mt, __shfl_xor(mt, 32));
            const float m_new = fmaxf(m_run, mt), alpha = __builtin_amdgcn_exp2f(m_run - m_new); m_run = m_new;
            float ls = 0.f;
#pragma unroll
            for (int r = 0; r < 16; ++r) { p[r] = __builtin_amdgcn_exp2f(p[r] - m_new); ls += p[r]; }
            l_run = l_run * alpha + ls;
#pragma unroll
            for (int r = 0; r < 16; ++r) { o0[r] *= alpha; o1[r] *= alpha; }
            v4u pw0, pw1;
            pw0.x = cvtpk(p[0], p[1]); pw0.y = cvtpk(p[2], p[3]); pw0.z = cvtpk(p[4], p[5]); pw0.w = cvtpk(p[6], p[7]);
            pw1.x = cvtpk(p[8], p[9]); pw1.y = cvtpk(p[10], p[11]); pw1.z = cvtpk(p[12], p[13]); pw1.w = cvtpk(p[14], p[15]);
            const bf16x8 pb0 = __builtin_bit_cast(bf16x8, pw0), pb1 = __builtin_bit_cast(bf16x8, pw1);
#pragma unroll
            for (int dt = 0; dt < 2; ++dt) {
#pragma unroll
                for (int s = 0; s < 2; ++s) {
                    const s16x4 lo = vtr(vrd + (16 * s) * VST + dt * 64), h8 = vtr(vrd + (16 * s + 8) * VST + dt * 64);
                    const bf16x8 af = (bf16x8){lo[0], lo[1], lo[2], lo[3], h8[0], h8[1], h8[2], h8[3]};
                    if (dt == 0) o0 = __builtin_amdgcn_mfma_f32_32x32x16_bf16(af, s == 0 ? pb0 : pb1, o0, 0, 0, 0);
                    else         o1 = __builtin_amdgcn_mfma_f32_32x32x16_bf16(af, s == 0 ? pb0 : pb1, o1, 0, 0, 0);
                }
            }
        }
        const float l_tot = l_run + __shfl_xor(l_run, 32), inv = 1.0f / l_tot;
        bf16* op = OG + ((size_t)g * MC + rowq) * 256 + hh * 64 + 4 * hi;
#pragma unroll
        for (int k = 0; k < 4; ++k) {
            v2u w0, w1;
            w0.x = cvtpk(o0[4 * k] * inv, o0[4 * k + 1] * inv); w0.y = cvtpk(o0[4 * k + 2] * inv, o0[4 * k + 3] * inv);
            w1.x = cvtpk(o1[4 * k] * inv, o1[4 * k + 1] * inv); w1.y = cvtpk(o1[4 * k + 2] * inv, o1[4 * k + 3] * inv);
            *(v2u*)(op + 8 * k) = w0; *(v2u*)(op + 32 + 8 * k) = w1;
        }
        if (hi == 0) LSE[((size_t)g * MC + rowq) * 4 + hh] = m_run + __builtin_amdgcn_logf(l_tot);
    }
}

__device__ __forceinline__ void loadu(const bf16* Zc, int row, int col, float (&u)[8]) {
    const v4u cc = *(const v4u*)(Zc + (size_t)row * INW + ZCC + col), hh = *(const v4u*)(Zc + (size_t)row * INW + ZCH + col);
    u[0] = blo(cc.x) * blo(hh.x); u[1] = bhi(cc.x) * bhi(hh.x); u[2] = blo(cc.y) * blo(hh.y); u[3] = bhi(cc.y) * bhi(hh.y);
    u[4] = blo(cc.z) * blo(hh.z); u[5] = bhi(cc.z) * bhi(hh.z); u[6] = blo(cc.w) * blo(hh.w); u[7] = bhi(cc.w) * bhi(hh.w);
}
__device__ __forceinline__ void combine_conv_phase(const bf16* Zc, const bf16* OG, const float* LSE, bf16* ATT, bf16* CBUF, const float* convw, int blk, int G) {
    int tid_ = threadIdx.x; asm volatile("" : "+v"(tid_));
    const int gt = blk * 512 + tid_, NT = G * 512;
    for (int idx = gt; idx < MC * 32; idx += NT) {
        const int row = idx >> 5, c8 = idx & 31, hh = c8 >> 3;
        const float l0 = LSE[((size_t)0 * MC + row) * 4 + hh], l1 = LSE[((size_t)1 * MC + row) * 4 + hh], l2 = LSE[((size_t)2 * MC + row) * 4 + hh];
        const float mx = fmaxf(l0, fmaxf(l1, l2));
        float w0 = __builtin_amdgcn_exp2f(l0 - mx), w1 = __builtin_amdgcn_exp2f(l1 - mx), w2 = __builtin_amdgcn_exp2f(l2 - mx);
        const float inv = 1.0f / (w0 + w1 + w2); w0 *= inv; w1 *= inv; w2 *= inv;
        const v4u a = *(const v4u*)(OG + ((size_t)0 * MC + row) * 256 + c8 * 8), b = *(const v4u*)(OG + ((size_t)1 * MC + row) * 256 + c8 * 8), c = *(const v4u*)(OG + ((size_t)2 * MC + row) * 256 + c8 * 8);
        v4u o;
        o.x = cvtpk(w0 * blo(a.x) + w1 * blo(b.x) + w2 * blo(c.x), w0 * bhi(a.x) + w1 * bhi(b.x) + w2 * bhi(c.x));
        o.y = cvtpk(w0 * blo(a.y) + w1 * blo(b.y) + w2 * blo(c.y), w0 * bhi(a.y) + w1 * bhi(b.y) + w2 * bhi(c.y));
        o.z = cvtpk(w0 * blo(a.z) + w1 * blo(b.z) + w2 * blo(c.z), w0 * bhi(a.z) + w1 * bhi(b.z) + w2 * bhi(c.z));
        o.w = cvtpk(w0 * blo(a.w) + w1 * blo(b.w) + w2 * blo(c.w), w0 * bhi(a.w) + w1 * bhi(b.w) + w2 * bhi(c.w));
        *(v4u*)(ATT + (size_t)row * 256 + c8 * 8) = o;
    }
    for (int idx = gt; idx < (MC / 16) * 128; idx += NT) {
        const int cg8 = idx & 127, rb = idx >> 7, col = cg8 * 8, t0 = rb * 16;
        float k0[8], k1[8], k2[8];
#pragma unroll
        for (int j = 0; j < 8; ++j) { k0[j] = convw[col + j]; k1[j] = convw[D + col + j]; k2[j] = convw[2 * D + col + j]; }
        float up[8], uc[8], un[8];
        if ((t0 & (SEQ - 1)) == 0) {
#pragma unroll
            for (int j = 0; j < 8; ++j) up[j] = 0.f;
        } else loadu(Zc, t0 - 1, col, up);
        loadu(Zc, t0, col, uc);
        for (int i = 0; i < 16; ++i) {
            const int row = t0 + i;
            if (((row + 1) & (SEQ - 1)) == 0) {
#pragma unroll
                for (int j = 0; j < 8; ++j) un[j] = 0.f;
            } else loadu(Zc, row + 1, col, un);
            const v4u bb = *(const v4u*)(Zc + (size_t)row * INW + ZCB + col);
            float cv[8];
#pragma unroll
            for (int j = 0; j < 8; ++j) cv[j] = up[j] * k0[j] + uc[j] * k1[j] + un[j] * k2[j];
            v4u o;
            o.x = cvtpk(blo(bb.x) * cv[0], bhi(bb.x) * cv[1]); o.y = cvtpk(blo(bb.y) * cv[2], bhi(bb.y) * cv[3]);
            o.z = cvtpk(blo(bb.z) * cv[4], bhi(bb.z) * cv[5]); o.w = cvtpk(blo(bb.w) * cv[6], bhi(bb.w) * cv[7]);
            *(v4u*)(CBUF + (size_t)row * D + col) = o;
#pragma unroll
            for (int j = 0; j < 8; ++j) { up[j] = uc[j]; uc[j] = un[j]; }
        }
    }
}

template <bool SRC_F32, bool DST_F32>
__device__ __forceinline__ void resid_norm_phase(const float* xi_a, const float* xi_b, int rowbase, const bf16* Y, const float* PART, const float* g, float* xo, bf16* XBc, float* RSc,
                                                 int blk, int G, int wave, int lane) {
    constexpr int RU = 4;
    const int NGW = G * NWAVES;
    f32x4 gv[4];
#pragma unroll
    for (int j = 0; j < 4; ++j) gv[j] = *((const f32x4*)g + lane + 64 * j);
    for (int lr0 = blk * NWAVES + wave; lr0 < MC; lr0 += RU * NGW) {
        f32x4 xv[RU][4]; v2u yv[RU][4]; f32x4 pv[RU][4];
#pragma unroll
        for (int u = 0; u < RU; ++u) {
            const int lr = lr0 + u * NGW; if (lr < MC) {
                const int row = rowbase + lr;
                const float* xr = row < NPROMPT_ROWS ? xi_a + (size_t)row * D : xi_b + (size_t)(row - NPROMPT_ROWS) * D;
#pragma unroll
                for (int j = 0; j < 4; ++j) {
                    if (SRC_F32) xv[u][j] = *((const f32x4*)xr + lane + 64 * j);
                    else { const v2u t = *((const v2u*)(XBc + (size_t)lr * D) + lane + 64 * j); xv[u][j] = (f32x4){blo(t.x), bhi(t.x), blo(t.y), bhi(t.y)}; }
                    yv[u][j] = *((const v2u*)(Y + (size_t)lr * D) + lane + 64 * j); pv[u][j] = *((const f32x4*)(PART + (size_t)lr * 16) + j); }
            }
        }
#pragma unroll
        for (int u = 0; u < RU; ++u) {
            const int lr = lr0 + u * NGW; if (lr < MC) {
                const int row = rowbase + lr;
                const f32x4 p0 = pv[u][0], p1 = pv[u][1], p2 = pv[u][2], p3 = pv[u][3];
                const float ssy = ((p0[0] + p0[1]) + (p0[2] + p0[3])) + ((p1[0] + p1[1]) + (p1[2] + p1[3])) + ((p2[0] + p2[1]) + (p2[2] + p2[3])) + ((p3[0] + p3[1]) + (p3[2] + p3[3]));
                const float rsy = 1.0f / sqrtf(ssy * (1.0f / D) + NORM_EPS);
                float ss = 0.f;
#pragma unroll
                for (int j = 0; j < 4; ++j) {
                    const f32x4 x4 = xv[u][j]; const v2u y2 = yv[u][j];
                    f32x4 o;
                    o[0] = x4[0] + blo(y2.x) * rsy * gv[j][0]; o[1] = x4[1] + bhi(y2.x) * rsy * gv[j][1]; o[2] = x4[2] + blo(y2.y) * rsy * gv[j][2]; o[3] = x4[3] + bhi(y2.y) * rsy * gv[j][3];
                    if (DST_F32) *((f32x4*)(xo + (size_t)row * D) + lane + 64 * j) = o;
                    else { v2u w; w.x = cvtpk(o[0], o[1]); w.y = cvtpk(o[2], o[3]); *((v2u*)(XBc + (size_t)lr * D) + lane + 64 * j) = w;
                        const float r0 = blo(w.x), r1 = bhi(w.x), r2 = blo(w.y), r3 = bhi(w.y); ss += (r0 * r0 + r1 * r1) + (r2 * r2 + r3 * r3); }
                }
                if (!DST_F32) { ss = wave_sum(ss); if (lane == 0) RSc[lr] = 1.0f / sqrtf(ss * (1.0f / D) + NORM_EPS); }
            }
        }
    }
}

#define XB_TMO      128
#define XB_XCNT(j)  (256  + 64 * (j))
#define XB_XSUB(j)  (1280 + 64 * (j))
#define XB_XGEN(j)  (2304 + 64 * (j))
#define XB_TOP      3328
#define XB_TOPGEN   3392
#define XCD_BAR_WORDS 3456
#define XB_SPIN_CAP (1u << 18)

__device__ __forceinline__ unsigned xb_ld(unsigned* p)              { return __hip_atomic_load(p, __ATOMIC_RELAXED, __HIP_MEMORY_SCOPE_AGENT); }
__device__ __forceinline__ unsigned xb_add(unsigned* p, unsigned v) { return __hip_atomic_fetch_add(p, v, __ATOMIC_RELAXED, __HIP_MEMORY_SCOPE_AGENT); }
__device__ __forceinline__ unsigned xb_xcc_id() { return (unsigned)__builtin_amdgcn_s_getreg((3 << 11) | 20) & 0xFu; }
#define XB_SPIN(cond, bar) do { unsigned _sp = 0; while (cond) { __builtin_amdgcn_s_sleep(1); \
    if ((++_sp & 255u) == 0u) { if (xb_ld(&(bar)[XB_TMO])) break; if (_sp > XB_SPIN_CAP) { atomicAdd(&(bar)[XB_TMO], 1u); break; } } } } while (0)

struct XcdBarrier {
    unsigned* bar; unsigned x;
    volatile LAS unsigned* st;
};

__device__ __forceinline__ XcdBarrier xcd_barrier_post(unsigned* bar, volatile LAS unsigned* st) {
    XcdBarrier b; b.bar = bar; b.x = xb_xcc_id(); b.st = st;
    if (threadIdx.x == 0) (void)xb_add(&bar[XB_XCNT(b.x)], 1u);
    return b;
}
__device__ __forceinline__ void xcd_barrier_complete(unsigned* bar, unsigned x, unsigned& nloc, unsigned& nx) {
    const unsigned G = gridDim.x * gridDim.y * gridDim.z;
    unsigned sum, cnt, mine, sp = 0u;
    for (;;) {
        sum = 0u; cnt = 0u; mine = 0u;
#pragma unroll
        for (unsigned j = 0; j < 16; ++j) { const unsigned c = xb_ld(&bar[XB_XCNT(j)]); sum += c; cnt += (c > 0u) ? 1u : 0u; mine = (j == x) ? c : mine; }
        if (sum == G) break;
        __builtin_amdgcn_s_sleep(1);
        if ((++sp & 255u) == 0u) { if (xb_ld(&bar[XB_TMO])) break; if (sp > XB_SPIN_CAP) { atomicAdd(&bar[XB_TMO], 1u); break; } }
    }
    nloc = mine > 0u ? mine : 1u; nx = cnt > 0u ? cnt : 1u;
}

__device__ __forceinline__ void xcd_barrier(const XcdBarrier& b) {
    asm volatile("s_waitcnt vmcnt(0)" ::: "memory");
    __syncthreads();
    if (threadIdx.x == 0) {
        unsigned* bar = b.bar;
        __builtin_amdgcn_s_waitcnt(0);
        unsigned nloc = b.st[0], nx = b.st[1];
        if (nloc == 0u) { xcd_barrier_complete(bar, b.x, nloc, nx); b.st[0] = nloc; b.st[1] = nx; }
        const unsigned old = xb_add(&bar[XB_XSUB(b.x)], 1u);
        const unsigned gen = old / nloc;
        if (old + 1u == (gen + 1u) * nloc) {
            __builtin_amdgcn_fence(__ATOMIC_RELEASE, "agent");
            asm volatile("s_waitcnt vmcnt(0)" ::: "memory");
            const unsigned og = xb_add(&bar[XB_TOP], 1u);
            const unsigned tg = og / nx;
            if (og + 1u == (tg + 1u) * nx) xb_add(&bar[XB_TOPGEN], 1u);
            else XB_SPIN(xb_ld(&bar[XB_TOPGEN]) == tg, bar);
            __builtin_amdgcn_fence(__ATOMIC_ACQUIRE, "agent");
            xb_add(&bar[XB_XGEN(b.x)], 1u);
            asm volatile("s_waitcnt vmcnt(0)" ::: "memory");
        } else {
            XB_SPIN(xb_ld(&bar[XB_XGEN(b.x)]) == gen, bar);
            __builtin_amdgcn_fence(__ATOMIC_ACQUIRE, "agent");
            asm volatile("s_waitcnt vmcnt(0)" ::: "memory");
        }
    }
    __syncthreads();
}

__device__ __forceinline__ KArgs kargs() { auto p = __builtin_amdgcn_kernarg_segment_ptr(); asm volatile("" : "+s"(p)); return (KArgs)p; }
#ifndef PHM
#define PHM 0xFFFF
#endif
#ifndef REP_GEMM
#define REP_GEMM 1
#endif
#ifndef REP_ATT
#define REP_ATT 1
#endif
#ifndef REP_CC
#define REP_CC 1
#endif
#ifndef REP_SYNC
#define REP_SYNC 0
#endif
__global__ void __launch_bounds__(NWAVES * 64, 2) fwd_megakernel(Args a_unused) {
    extern __shared__ __attribute__((aligned(16))) unsigned char lds_raw[];
    cg::grid_group grid = cg::this_grid();
    LAS unsigned char* lds = (LAS unsigned char*)lds_raw;
#define XSYNC1() do { XcdBarrier b_; b_.bar = (unsigned*)(kargs()->ws + WS_BAR); b_.x = xb_xcc_id(); b_.st = (volatile LAS unsigned*)(lds + 131072); xcd_barrier(b_); } while (0)
#define GSYNC() do { XSYNC1(); for (int rs_ = 0; rs_ < REP_SYNC; ++rs_) XSYNC1(); } while (0)
    if (threadIdx.x == 0) { ((volatile LAS unsigned*)(lds + 131072))[0] = 0u; ((volatile LAS unsigned*)(lds + 131072))[1] = 0u; }
    __syncthreads();
    (void)xcd_barrier_post((unsigned*)(kargs()->ws + WS_BAR), (volatile LAS unsigned*)(lds + 131072));
#define WAVE_LANE int tid_ = threadIdx.x; asm volatile("" : "+v"(tid_)); const int lane = tid_ & 63, wave = __builtin_amdgcn_readfirstlane(tid_ >> 6)
#define BLK_G int blk = blockIdx.x, G = gridDim.x; asm volatile("" : "+s"(blk), "+s"(G))
#define WPTR(l, off) ((const bf16*)(ws + WS_W + (size_t)(l) * LW_SIZE + (off)))
    if constexpr ((PHM & 1) != 0) { WAVE_LANE; BLK_G; KArgs a = kargs(); p0_prologue(a, lds, blk, G, wave, lane); }
    grid.sync();

    for (int l = 0; l < DEPTH; ++l) {
        for (int ch = 0; ch < NCHUNK; ++ch) {
            for (int rep_ = 0; rep_ < REP_GEMM; ++rep_) if constexpr ((PHM & 2) != 0) {
                BLK_G; KArgs A = kargs(); unsigned char* ws = A->ws; const int rowbase = ch * MC;
                pg8::Gemm g{(const bf16*)(ws + WS_XB) + (size_t)rowbase * D, WPTR(l, LW_IN), MC, INW, D}; pg8::StaticOrder S; S.init(MC, INW, G, blk);
                pg8::EpiIn E{(bf16*)(ws + WS_Z), (const float*)(ws + WS_RS) + rowbase, (const float*)(ws + WS_ROPE), INW};
                pg8::gemm_phase<pg8::EpiIn, pg8::StaticOrder, true, true>(lds, g, S, E);
            }
            GSYNC();
            for (int rep_ = 0; rep_ < REP_ATT; ++rep_) if constexpr ((PHM & 4) != 0) { WAVE_LANE; BLK_G; KArgs A = kargs(); unsigned char* ws = A->ws;
                attn_phase(lds, (const bf16*)(ws + WS_Z), (bf16*)(ws + WS_OG), (float*)(ws + WS_LSE), blk, G, wave, lane); }
            GSYNC();
            for (int rep_ = 0; rep_ < REP_CC; ++rep_) if constexpr ((PHM & 8) != 0) { BLK_G; KArgs A = kargs(); unsigned char* ws = A->ws;
                combine_conv_phase((const bf16*)(ws + WS_Z), (const bf16*)(ws + WS_OG), (const float*)(ws + WS_LSE), (bf16*)(ws + WS_ATT), (bf16*)(ws + WS_RA), A->in[8] + (size_t)l * 3 * D, blk, G); }
            GSYNC();
            for (int rep_ = 0; rep_ < REP_GEMM; ++rep_) {
            if constexpr ((PHM & 16) != 0) {
                BLK_G; KArgs A = kargs(); unsigned char* ws = A->ws;
                pg8::Gemm g{(const bf16*)(ws + WS_ATT), WPTR(l, LW_A), MC, D, 256}; pg8::StaticOrder S; S.init(MC, D, G, blk);
                pg8::EpiGate<false> E{(const bf16*)(ws + WS_Z) + ZGA, INW, (bf16*)(ws + WS_RB), D};
                pg8::gemm_phase<pg8::EpiGate<false>, pg8::StaticOrder, true, true>(lds, g, S, E);
            }
            if constexpr ((PHM & 32) != 0) {
                BLK_G; KArgs A = kargs(); unsigned char* ws = A->ws;
                pg8::Gemm g{(const bf16*)(ws + WS_RA), WPTR(l, LW_C), MC, D, D}; pg8::StaticOrder S; S.init(MC, D, G, blk);
                pg8::EpiGate<true> E{(const bf16*)(ws + WS_Z) + ZGC, INW, (bf16*)(ws + WS_RB), D};
                pg8::gemm_phase<pg8::EpiGate<true>, pg8::StaticOrder, true, true>(lds, g, S, E);
            }
            }
            GSYNC();
            for (int rep_ = 0; rep_ < REP_GEMM; ++rep_) if constexpr ((PHM & 64) != 0) {
                BLK_G; KArgs A = kargs(); unsigned char* ws = A->ws;
                pg8::Gemm g{(const bf16*)(ws + WS_RB), WPTR(l, LW_O), MC, D, D}; pg8::StaticOrder S; S.init(MC, D, G, blk);
                pg8::EpiSq E{(bf16*)(ws + WS_RA), D, (float*)(ws + WS_PART)};
                pg8::gemm_phase<pg8::EpiSq, pg8::StaticOrder, true, true>(lds, g, S, E);
            }
            GSYNC();
            if constexpr ((PHM & 128) != 0) { WAVE_LANE; BLK_G; KArgs A = kargs(); unsigned char* ws = A->ws; const int rowbase = ch * MC;
                if (l == 0) resid_norm_phase<true, false>(A->in[0], A->in[1], rowbase, (const bf16*)(ws + WS_RA), (const float*)(ws + WS_PART), A->in[3] + l * D, nullptr, (bf16*)(ws + WS_XB) + (size_t)rowbase * D, (float*)(ws + WS_RS) + rowbase, blk, G, wave, lane);
                else        resid_norm_phase<false, false>(nullptr, nullptr, rowbase, (const bf16*)(ws + WS_RA), (const float*)(ws + WS_PART), A->in[3] + l * D, nullptr, (bf16*)(ws + WS_XB) + (size_t)rowbase * D, (float*)(ws + WS_RS) + rowbase, blk, G, wave, lane); }
            GSYNC();
            for (int rep_ = 0; rep_ < REP_GEMM; ++rep_) if constexpr ((PHM & 256) != 0) {
                BLK_G; KArgs A = kargs(); unsigned char* ws = A->ws; const int rowbase = ch * MC;
                pg8::Gemm g{(const bf16*)(ws + WS_XB) + (size_t)rowbase * D, WPTR(l, LW_UP), MC, FF, D}; pg8::StaticOrder S; S.init(MC, FF, G, blk);
                pg8::EpiUp E{(bf16*)(ws + WS_Z), FF, (const float*)(ws + WS_RS) + rowbase};
                pg8::gemm_phase<pg8::EpiUp, pg8::StaticOrder, true, true>(lds, g, S, E);
            }
            GSYNC();
            for (int rep_ = 0; rep_ < REP_GEMM; ++rep_) if constexpr ((PHM & 512) != 0) {
                BLK_G; KArgs A = kargs(); unsigned char* ws = A->ws;
                pg8::Gemm g{(const bf16*)(ws + WS_Z), WPTR(l, LW_DN), MC, D, FF}; pg8::StaticOrder S; S.init(MC, D, G, blk);
                pg8::EpiSq E{(bf16*)(ws + WS_RA), D, (float*)(ws + WS_PART)};
                pg8::gemm_phase<pg8::EpiSq, pg8::StaticOrder, true, true>(lds, g, S, E);
            }
            GSYNC();
            if constexpr ((PHM & 1024) != 0) { WAVE_LANE; BLK_G; KArgs A = kargs(); unsigned char* ws = A->ws; const int rowbase = ch * MC;
                if (l == DEPTH - 1) resid_norm_phase<false, true>(nullptr, nullptr, rowbase, (const bf16*)(ws + WS_RA), (const float*)(ws + WS_PART), A->in[5] + l * D, A->out, (bf16*)(ws + WS_XB) + (size_t)rowbase * D, (float*)(ws + WS_RS) + rowbase, blk, G, wave, lane);
                else                resid_norm_phase<false, false>(nullptr, nullptr, rowbase, (const bf16*)(ws + WS_RA), (const float*)(ws + WS_PART), A->in[5] + l * D, nullptr, (bf16*)(ws + WS_XB) + (size_t)rowbase * D, (float*)(ws + WS_RS) + rowbase, blk, G, wave, lane); }
        }
    }
}

extern "C" void kernel_launch(void* const* d_in, const int* in_sizes, int n_in, void* d_out, int out_size, void* d_ws, size_t ws_size, hipStream_t stream) {
    static int grid = 0;
    if (grid == 0) {
        if (n_in != 13 || out_size != M * D || ws_size < WS_END) { fprintf(stderr, "kernel_launch: unexpected shapes / workspace (%d inputs, out %d, ws %zu < %zu)\n", n_in, out_size, ws_size, (size_t)WS_END); grid = -1; return; }
        int dev = 0, cus = 0, per_cu = 0;
        (void)hipGetDevice(&dev); (void)hipDeviceGetAttribute(&cus, hipDeviceAttributeMultiprocessorCount, dev);
        (void)hipFuncSetAttribute((const void*)fwd_megakernel, hipFuncAttributeMaxDynamicSharedMemorySize, LDS_BYTES);
        if (hipOccupancyMaxActiveBlocksPerMultiprocessor(&per_cu, (const void*)fwd_megakernel, NWAVES * 64, LDS_BYTES) != hipSuccess || per_cu < 1) per_cu = 1;
        (void)hipGetLastError();
        grid = cus * per_cu;
        if (grid <= 0) grid = 256;
    }
    if (grid < 0) return;
    Args a{};
    for (int i = 0; i < 13; ++i) a.in[i] = (const float*)d_in[i];
    a.out = (float*)d_out; a.ws = (unsigned char*)d_ws;
    (void)hipMemsetAsync((unsigned char*)d_ws + WS_BAR, 0, 16384, stream);
    void* args[] = {&a};
    hipError_t e = hipLaunchCooperativeKernel((const void*)fwd_megakernel, dim3(grid), dim3(NWAVES * 64), args, LDS_BYTES, stream);
    if (e != hipSuccess) fprintf(stderr, "cooperative launch failed: %s (grid %d)\n", hipGetErrorString(e), grid);
}
```
